# Optimizing an MI355X kernel written in HIP

```python
import jax, jax.numpy as jnp
from jax import lax
import numpy as np

D_MODEL = 2048
BATCH = 4
SEQ = 2048
DEPTH = 1
DEC_BATCH = 128
DEC_SEQ = 8
PAST_LEN = 16384
PAGE_SIZE = 128

D_MIX = D_MODEL
D_A = (3 * D_MIX) // 8
D_B = (3 * D_MIX) // 8
D_X = D_MIX - D_A - D_B
H_A = 4
HD_A = D_A // H_A
CHUNK_A = 128
H_B = 4
DV_B = D_B // H_B
DK_B = DV_B // 2
D_BK = H_B * DK_B
GATE_RANK = 16
GATE_TAU = 16.0
CHUNK_B = 64
H_X = 4
HD_X = D_X // H_X
N_MEM = 256
EPS = 1e-6
IN_WIDTHS = (D_A, D_A, D_A, D_BK, D_BK, D_B, GATE_RANK, D_B, D_X, D_X)
D_IN = sum(IN_WIDTHS)

kernel_name = "hybrid_chunkmlp_gla_memxattn_step"


def rmsnorm(x, w):
    xf = x.astype(jnp.float32)
    y = xf * lax.rsqrt(jnp.mean(xf * xf, axis=-1, keepdims=True) + EPS)
    return (y * w.astype(jnp.float32)).astype(x.dtype)


def split_points():
    return [int(c) for c in np.cumsum(IN_WIDTHS)[:-1]]


def spatial_gating(u, v, w_s, b_s):
    bn, t = u.shape[0], u.shape[1]
    ln = min(t, CHUNK_A)
    n = t // ln
    mask = jnp.tril(jnp.ones((ln, ln), dtype=bool))
    w = jnp.where(mask, w_s[:, :ln, :ln], 0)
    vc = v.reshape(bn, n, ln, H_A, HD_A)
    mixed = jnp.einsum('hij,bnjhd->bnihd', w, vc) + b_s[:, :ln].T[None, None, :, :, None]
    return u * mixed.reshape(bn, t, H_A, HD_A)


def gla(q, k, v, log_a, s0):
    f32 = jnp.float32
    bn, t, h, dk = q.shape
    dv = v.shape[-1]
    c = min(t, CHUNK_B)
    n = t // c
    qc = q.astype(f32).reshape(bn, n, c, h, dk) * (dk ** -0.5)
    kc = k.astype(f32).reshape(bn, n, c, h, dk)
    vc = v.astype(f32).reshape(bn, n, c, h, dv)
    cum = jnp.cumsum(log_a.astype(f32).reshape(bn, n, c, h, dk), axis=2)
    q_in = qc * jnp.exp(cum)
    k_in = kc * jnp.exp(-cum)
    k_out = kc * jnp.exp(cum[:, :, -1:] - cum)
    decay = jnp.exp(cum[:, :, -1])
    mask = jnp.tril(jnp.ones((c, c), dtype=bool))
    scores = jnp.where(mask, jnp.einsum('bnihd,bnjhd->bnhij', q_in, k_in), 0.0)
    o_intra = jnp.einsum('bnhij,bnjhe->bnihe', scores, vc)

    def step(s, inp):
        q_i, k_o, v_i, dec = inp
        o = jnp.einsum('bihd,bhde->bihe', q_i, s)
        s = dec[..., None] * s + jnp.einsum('bjhd,bjhe->bhde', k_o, v_i)
        return s, o

    xs = (jnp.moveaxis(q_in, 1, 0), jnp.moveaxis(k_out, 1, 0),
          jnp.moveaxis(vc, 1, 0), jnp.moveaxis(decay, 1, 0))
    s_fin, o_inter = lax.scan(step, s0.astype(f32), xs)
    o = o_intra + jnp.moveaxis(o_inter, 0, 1)
    return o.reshape(bn, t, h, dv), s_fin


def memory_kv(mem, mem_norm_w, w_mem_kv):
    m = rmsnorm(mem, mem_norm_w) @ w_mem_kv
    mk, mv = jnp.split(m, 2, axis=-1)
    bn = mem.shape[0]
    return mk.reshape(bn, N_MEM, H_X, HD_X), mv.reshape(bn, N_MEM, H_X, HD_X)


def memory_attention(q, mk, mv):
    s = jnp.einsum('bthd,bnhd->bhtn', q, mk).astype(jnp.float32) * (HD_X ** -0.5)
    p = jax.nn.softmax(s, axis=-1)
    return jnp.einsum('bhtn,bnhd->bthd', p.astype(mv.dtype), mv)


def mixer_layer(x, mk, mv, s0, norm_w, w_in, a_vnorm_w, a_ws, a_bs,
                b_wa, b_ba, b_onorm_w, w_out):
    bn, t, _ = x.shape
    h = rmsnorm(x, norm_w)
    proj = h @ w_in
    a_u, a_v, a_g, b_q, b_k, b_v, b_r, b_g, x_q, x_g = jnp.split(proj, split_points(), axis=-1)
    a_vn = rmsnorm(a_v, a_vnorm_w)
    a_o = spatial_gating(a_u.reshape(bn, t, H_A, HD_A), a_vn.reshape(bn, t, H_A, HD_A),
                         a_ws, a_bs).reshape(bn, t, D_A)
    log_a = jax.nn.log_sigmoid((b_r @ b_wa + b_ba).astype(jnp.float32)) / GATE_TAU
    o_b, s_new = gla(b_q.reshape(bn, t, H_B, DK_B), b_k.reshape(bn, t, H_B, DK_B),
                     b_v.reshape(bn, t, H_B, DV_B), log_a.reshape(bn, t, H_B, DK_B), s0)
    o_b = rmsnorm(o_b, b_onorm_w).astype(x.dtype).reshape(bn, t, D_B)
    o_x = memory_attention(x_q.reshape(bn, t, H_X, HD_X), mk, mv).reshape(bn, t, D_X)
    branches = jnp.concatenate([a_o * jax.nn.silu(a_g),
                                o_b * jax.nn.silu(b_g),
                                o_x * jax.nn.silu(x_g)], axis=-1)
    y = x + branches @ w_out
    return y, a_vn, s_new.astype(x.dtype)


def setup_inputs(seed: int = 0) -> dict:
    key = jax.random.key(seed)
    ks = jax.random.split(key, 20)
    f32 = jnp.float32
    nrm = lambda k, s: jax.random.normal(k, s, f32)
    return {
        "x_prompt": nrm(ks[0], (BATCH, SEQ, D_MODEL)),
        "x_sample": nrm(ks[1], (DEC_BATCH, DEC_SEQ, D_MODEL)),
        "mem_prompt": nrm(ks[2], (BATCH, N_MEM, D_MODEL)),
        "state_gla": nrm(ks[3], (DEPTH, DEC_BATCH, H_B, DK_B, DV_B)),
        "cache_mem_k": nrm(ks[4], (DEPTH, DEC_BATCH, N_MEM, H_X, HD_X)),
        "cache_mem_v": nrm(ks[5], (DEPTH, DEC_BATCH, N_MEM, H_X, HD_X)),
        "norm_w": 1.0 + 0.02 * nrm(ks[6], (DEPTH, D_MODEL)),
        "w_in": nrm(ks[7], (DEPTH, D_MODEL, D_IN)) * D_MODEL ** -0.5,
        "a_vnorm_w": 1.0 + 0.02 * nrm(ks[8], (DEPTH, D_A)),
        "a_ws": nrm(ks[9], (DEPTH, H_A, CHUNK_A, CHUNK_A)) * CHUNK_A ** -0.5,
        "a_bs": 0.02 * nrm(ks[10], (DEPTH, H_A, CHUNK_A)),
        "b_wa": nrm(ks[11], (DEPTH, GATE_RANK, D_BK)) * GATE_RANK ** -0.5,
        "b_ba": 0.02 * nrm(ks[12], (DEPTH, D_BK)),
        "b_onorm_w": 1.0 + 0.02 * nrm(ks[13], (DEPTH, DV_B)),
        "mem_norm_w": 1.0 + 0.02 * nrm(ks[14], (DEPTH, D_MODEL)),
        "w_mem_kv": nrm(ks[15], (DEPTH, D_MODEL, 2 * D_X)) * D_MODEL ** -0.5,
        "w_out": nrm(ks[16], (DEPTH, D_MIX, D_MODEL)) * D_MIX ** -0.5,
        "final_norm_w": 1.0 + 0.02 * nrm(ks[17], (D_MODEL,)),
    }


def reference(x_prompt, x_sample, mem_prompt, state_gla, cache_mem_k, cache_mem_v,
              norm_w, w_in, a_vnorm_w, a_ws, a_bs, b_wa, b_ba, b_onorm_w,
              mem_norm_w, w_mem_kv, w_out, final_norm_w):
    bp = x_prompt.shape[0]
    hp, hs = x_prompt, x_sample
    mem_k_p, mem_v_p, st_p, st_s, av_s = [], [], [], [], []
    for l in range(DEPTH):
        layer_w = (norm_w[l], w_in[l], a_vnorm_w[l], a_ws[l], a_bs[l],
                   b_wa[l], b_ba[l], b_onorm_w[l], w_out[l])
        mk, mv = memory_kv(mem_prompt, mem_norm_w[l], w_mem_kv[l])
        s0 = jnp.zeros((bp, H_B, DK_B, DV_B), dtype=jnp.float32)
        hp, _, sp = mixer_layer(hp, mk, mv, s0, *layer_w)
        hs, avs, ss = mixer_layer(hs, cache_mem_k[l], cache_mem_v[l], state_gla[l], *layer_w)
        mem_k_p.append(mk)
        mem_v_p.append(mv)
        st_p.append(sp)
        st_s.append(ss)
        av_s.append(avs)
    y_prompt = rmsnorm(hp, final_norm_w)
    y_sample = rmsnorm(hs, final_norm_w)
    return (y_prompt, y_sample, jnp.stack(mem_k_p), jnp.stack(mem_v_p),
            jnp.stack(st_p), jnp.stack(st_s), jnp.stack(av_s))
```

```cpp
#include <hip/hip_runtime.h>
#include <cstdio>
#include <cstdint>

#define LAS __attribute__((address_space(3)))
typedef unsigned short bf16_t;
typedef short bf16x8 __attribute__((ext_vector_type(8)));
typedef float f32x4 __attribute__((ext_vector_type(4)));
typedef float f32x2 __attribute__((ext_vector_type(2)));
typedef unsigned u32x4 __attribute__((ext_vector_type(4)));
typedef unsigned u32x2 __attribute__((ext_vector_type(2)));

#ifndef N_LAUNCH_MODE
#define N_LAUNCH_MODE 5
#endif

constexpr int DM = 2048;
constexpr int NP = 8192, NS = 1024, NTOK = NP + NS, NMR = 1024;
constexpr int SEQ = 2048, DSEQ = 8, NB = 4, DB = 128, NMEM = 256;
constexpr int DIN = 5648, DINP = 5632;
constexpr int C_AU = 0, C_AV = 768, C_AG = 1536, C_BQ = 2304, C_BK = 2688, C_BV = 3072, C_BG = 3840, C_XQ = 4608, C_XG = 5120;
constexpr int SRC_BR = 3840;
constexpr float EPS = 1e-6f;
constexpr size_t O_Y = 0, O_MK = 18874368, O_MV = 19398656, O_SP = 19922944, O_SS = 20217856, O_CV = 29655040;
constexpr size_t MiB = 1u << 20;
constexpr size_t WS_CTL = 0, CTL_BYTES = 1 * MiB;
constexpr size_t WS_XB = 2 * MiB, WS_MB = 38 * MiB, WS_WIN = 42 * MiB, WS_WM = 64 * MiB, WS_WO = 68 * MiB, WS_WR = 76 * MiB, WS_BR = 77 * MiB,
                 WS_MKB = 78 * MiB, WS_MVB = 79 * MiB, WS_PROJ = 80 * MiB, WS_BRANCH = 180 * MiB, WS_END = 216 * MiB;
constexpr int LDS_BYTES = 147456;
constexpr int NTHREADS = 512;

struct Params {
    const float *x_prompt, *x_sample, *mem, *state, *cache_k, *cache_v, *norm_w, *w_in, *a_vnorm_w, *a_ws, *a_bs, *b_wa, *b_ba, *b_onorm_w,
                *mem_norm_w, *w_mem, *w_out, *final_w;
    float* out; unsigned char* ws;
    int ph_lo, ph_hi;
};

__device__ __forceinline__ unsigned f2bf(float f) { unsigned u = __builtin_bit_cast(unsigned, f); return (u + 0x7fffu + ((u >> 16) & 1u)) >> 16; }
__device__ __forceinline__ unsigned pk2(float lo, float hi) { return f2bf(lo) | (f2bf(hi) << 16); }
__device__ __forceinline__ float bflo(unsigned w) { return __builtin_bit_cast(float, w << 16); }
__device__ __forceinline__ float bfhi(unsigned w) { return __builtin_bit_cast(float, w & 0xffff0000u); }
__device__ __forceinline__ float bf2f(bf16_t b) { return __builtin_bit_cast(float, ((unsigned)b) << 16); }
__device__ __forceinline__ unsigned cvt_pk_bf16(float lo, float hi) { unsigned r; asm volatile("v_cvt_pk_bf16_f32 %0, %1, %2" : "=v"(r) : "v"(lo), "v"(hi)); return r; }
__device__ __forceinline__ float wave_sum(float v) {
#pragma unroll
    for (int o = 1; o < 64; o <<= 1) v += __shfl_xor(v, o);
    return v;
}
__device__ __forceinline__ float wave_max(float v) {
#pragma unroll
    for (int o = 1; o < 64; o <<= 1) v = fmaxf(v, __shfl_xor(v, o));
    return v;
}
__device__ __forceinline__ float silu(float x) { return x / (1.0f + __expf(-x)); }

namespace pg8 {
constexpr int BM = 256, BK = 64, HALF = 128, HTB = HALF * BK * 2, STAGE_BYTES = 8 * HTB, NXCD = 8, WGM = 8;
constexpr int K = DM, NT = K / BK;
constexpr size_t TSTEP = (size_t)BM * K * 2;
__device__ __forceinline__ int lds_byte(int r, int c) { const int st = (r >> 4) * 2 + (c >> 5), rr = r & 15, cc = c & 31, ob = rr * 64 + cc * 2; return st * 1024 + (ob ^ (((ob >> 9) & 1) << 5)); }
__device__ __forceinline__ void stage_rc(int b, int& R, int& C) { const int st = b / 1024, sb = b % 1024, swz = sb ^ (((sb >> 9) & 1) << 5); R = (st >> 1) * 16 + swz / 64; C = (st & 1) * 32 + (swz % 64) / 2; }
__device__ __forceinline__ int perm32(int rho) { const int n = rho >> 4, i = rho & 15; return 8 * (i >> 2) + 4 * n + (i & 3); }
struct Unit { int pm, pn, kind; };
__device__ __forceinline__ void static_tile(int L, int nM, int nN, int& pm, int& pn) {
    const int nwg = nM * nN; int wgid = L; { const int q = nwg / NXCD, r = nwg % NXCD, xcd = wgid % NXCD, off = wgid / NXCD; wgid = (xcd < r ? xcd * (q + 1) : r * (q + 1) + (xcd - r) * q) + off; }
    const int nig = WGM * nN, gid = wgid / nig, fm = gid * WGM, gsz = (nM - fm) < WGM ? (nM - fm) : WGM;
    pm = fm + ((wgid % nig) % gsz); pn = (wgid % nig) / gsz;
}
typedef f32x4 Acc[2][2][4][2];

template <class Prog>
__device__ __forceinline__ void gemm_phase(LAS unsigned char* lds, const Prog& P) {
    const int tid = threadIdx.x, wid = __builtin_amdgcn_readfirstlane(tid >> 6), lane = tid & 63, wr = wid >> 2, wc = wid & 3, fr = lane & 15, fq = lane >> 4;
    unsigned voffA[2], voffB[2];
#pragma unroll
    for (int i = 0; i < 2; ++i) { int R, C; stage_rc(tid * 16 + i * 8192, R, C); const int Rb = (R & ~31) + perm32(R & 31);
        voffA[i] = (unsigned)(R * K + C) * 2u; voffB[i] = (unsigned)(Rb * K + C) * 2u; }
    const size_t kstep = (size_t)(BK * 2);
    const size_t hstep = (size_t)HALF * K * 2;
    const unsigned ldsw = (unsigned)wid * 1024u;
    const int aoff = lds_byte(wr * 64 + fr, fq * 8), boff = lds_byte(wc * 32 + fr, fq * 8);
#define PG8_SA(b, h) (((b) * 2 + (h)) * HTB)
#define PG8_SB(b, h) ((4 + (b) * 2 + (h)) * HTB)
#define PG8_STAGE(bufoff, gbase, voff) do { _Pragma("unroll") for (int _i = 0; _i < 2; ++_i) \
        __builtin_amdgcn_global_load_lds((const unsigned*)((const char*)(gbase) + (voff)[_i]), (LAS unsigned*)(lds + (bufoff) + ldsw + _i * 8192), 16, 0, 0); } while (0)
#define PG8_LDA(dst, b, h) do { _Pragma("unroll") for (int m = 0; m < 4; ++m) _Pragma("unroll") for (int k = 0; k < 2; ++k) dst[m][k] = *(const LAS bf16x8*)(lds + PG8_SA(b, h) + aoff + m * 2048 + k * 1024); } while (0)
#define PG8_LDB(dst, b, h) do { _Pragma("unroll") for (int n = 0; n < 2; ++n) _Pragma("unroll") for (int k = 0; k < 2; ++k) dst[n][k] = *(const LAS bf16x8*)(lds + PG8_SB(b, h) + boff + n * 2048 + k * 1024); } while (0)
#define PG8_MMA(ai, bj, At, Bt) do { __builtin_amdgcn_s_setprio(1); _Pragma("unroll") for (int m = 0; m < 4; ++m) _Pragma("unroll") for (int n = 0; n < 2; ++n) _Pragma("unroll") for (int k = 0; k < 2; ++k) \
        acc[ai][bj][m][n] = __builtin_amdgcn_mfma_f32_16x16x32_bf16(Bt[n][k], At[m][k], acc[ai][bj][m][n], 0, 0, 0); __builtin_amdgcn_s_setprio(0); } while (0)
#define PG8_WAIT_V(n) asm volatile("s_waitcnt vmcnt(" #n ")" ::: "memory")
#define PG8_WAIT_L(n) asm volatile("s_waitcnt lgkmcnt(" #n ")" ::: "memory")
#define PG8_BAR __builtin_amdgcn_s_barrier()
#define PG8_SCHED __builtin_amdgcn_sched_barrier(0)
    Unit cur, nxt; int ui = 0;
    if (!P.next(0, cur)) return;
    Acc acc;
#pragma unroll
    for (int a = 0; a < 2; ++a)
#pragma unroll
        for (int b = 0; b < 2; ++b)
#pragma unroll
            for (int m = 0; m < 4; ++m)
#pragma unroll
                for (int n = 0; n < 2; ++n) acc[a][b][m][n] = (f32x4){0.f, 0.f, 0.f, 0.f};
    bf16x8 At[4][2], B0[2][2], B1[2][2];
    const char* cA = P.a_ptr(cur); const char* cB = P.b_ptr(cur);
    PG8_STAGE(PG8_SB(0, 0), cB, voffB); PG8_STAGE(PG8_SA(0, 0), cA, voffA); PG8_STAGE(PG8_SB(0, 1), cB + hstep, voffB); PG8_STAGE(PG8_SA(0, 1), cA + hstep, voffA);
    if (wr == 1) PG8_BAR;
    PG8_WAIT_V(4); PG8_BAR;
    PG8_STAGE(PG8_SB(1, 0), cB + kstep, voffB); PG8_STAGE(PG8_SA(1, 0), cA + kstep, voffA); PG8_STAGE(PG8_SB(1, 1), cB + hstep + kstep, voffB);
    PG8_WAIT_V(6); PG8_BAR;
    for (;;) {
        const bool has_next = P.next(ui + 1, nxt);
        const char* nA = has_next ? P.a_ptr(nxt) : cA; const char* nB = has_next ? P.b_ptr(nxt) : cB;
        for (int t = 0; t < NT; t += 2) {
            const bool last = (t == NT - 2);
            const char* a1 = cA + (size_t)(t + 1) * kstep;
            const char* a2 = last ? nA : cA + (size_t)(t + 2) * kstep; const char* b2 = last ? nB : cB + (size_t)(t + 2) * kstep;
            const char* a3 = a2 + kstep; const char* b3 = b2 + kstep;
            PG8_LDB(B0, 0, 0); PG8_SCHED; PG8_LDA(At, 0, 0); PG8_STAGE(PG8_SA(1, 1), a1 + hstep, voffA);
            PG8_WAIT_L(8); PG8_BAR; PG8_WAIT_L(0); PG8_MMA(0, 0, At, B0); PG8_BAR; PG8_SCHED;
            PG8_LDB(B1, 0, 1); PG8_STAGE(PG8_SB(0, 0), b2, voffB);
            PG8_BAR; PG8_WAIT_L(0); PG8_MMA(0, 1, At, B1); PG8_BAR;
            PG8_LDA(At, 0, 1); PG8_STAGE(PG8_SA(0, 0), a2, voffA);
            PG8_BAR; PG8_WAIT_L(0); PG8_MMA(1, 0, At, B0); PG8_BAR; PG8_SCHED;
            PG8_STAGE(PG8_SB(0, 1), b2 + hstep, voffB);
            PG8_WAIT_V(6); PG8_BAR; PG8_MMA(1, 1, At, B1); PG8_BAR;
            PG8_LDB(B0, 1, 0); PG8_SCHED; PG8_LDA(At, 1, 0); PG8_STAGE(PG8_SA(0, 1), a2 + hstep, voffA);
            PG8_WAIT_L(8); PG8_BAR; PG8_WAIT_L(0); PG8_MMA(0, 0, At, B0); PG8_BAR; PG8_SCHED;
            PG8_LDB(B1, 1, 1); PG8_STAGE(PG8_SB(1, 0), b3, voffB);
            PG8_BAR; PG8_WAIT_L(0); PG8_MMA(0, 1, At, B1); PG8_BAR;
            PG8_LDA(At, 1, 1); PG8_STAGE(PG8_SA(1, 0), a3, voffA);
            PG8_BAR; PG8_WAIT_L(0); PG8_MMA(1, 0, At, B0); PG8_BAR; PG8_SCHED;
            PG8_STAGE(PG8_SB(1, 1), b3 + hstep, voffB);
            PG8_WAIT_V(6); PG8_BAR; PG8_MMA(1, 1, At, B1); PG8_BAR;
        }
        P.epi(acc, cur, wr, wc, fr, fq);
        if (!has_next) break;
#pragma unroll
        for (int a = 0; a < 2; ++a)
#pragma unroll
            for (int b = 0; b < 2; ++b)
#pragma unroll
                for (int m = 0; m < 4; ++m)
#pragma unroll
                    for (int n = 0; n < 2; ++n) acc[a][b][m][n] = (f32x4){0.f, 0.f, 0.f, 0.f};
        cur = nxt; cA = nA; cB = nB; ++ui;
    }
    PG8_WAIT_V(0);
    if (wr == 0) PG8_BAR;
    PG8_BAR;
#undef PG8_SA
#undef PG8_SB
#undef PG8_STAGE
#undef PG8_LDA
#undef PG8_LDB
#undef PG8_MMA
#undef PG8_WAIT_V
#undef PG8_WAIT_L
#undef PG8_BAR
#undef PG8_SCHED
}
}

struct Prog1 {
    const char *XB, *WIN, *MB, *WM; bf16_t* PROJ; float* out; bf16_t *MKB, *MVB; int G, c;
    __device__ __forceinline__ bool next(int i, pg8::Unit& u) const {
        const int L = i * G + c; if (L >= 808) return false;
        if (L < 792) { pg8::static_tile(L, 36, 22, u.pm, u.pn); u.kind = 0; } else { const int r = L - 792; u.pm = r >> 2; u.pn = r & 3; u.kind = 1; }
        return true;
    }
    __device__ __forceinline__ const char* a_ptr(const pg8::Unit& u) const { return (u.kind == 0 ? XB : MB) + (size_t)u.pm * pg8::TSTEP; }
    __device__ __forceinline__ const char* b_ptr(const pg8::Unit& u) const { return (u.kind == 0 ? WIN : WM) + (size_t)u.pn * pg8::TSTEP; }
    __device__ __forceinline__ void epi(const pg8::Acc& acc, const pg8::Unit& u, int wr, int wc, int fr, int fq) const {
        const int row0 = u.pm * 256 + wr * 64 + fr;
        if (u.kind == 0) {
            const int col0 = u.pn * 256 + wc * 32 + 8 * fq;
#pragma unroll
            for (int ai = 0; ai < 2; ++ai)
#pragma unroll
                for (int m = 0; m < 4; ++m) { bf16_t* rowp = PROJ + (size_t)(row0 + ai * 128 + m * 16) * DINP + col0;
#pragma unroll
                    for (int bj = 0; bj < 2; ++bj) { const f32x4 v0 = acc[ai][bj][m][0], v1 = acc[ai][bj][m][1];
                        u32x4 w; w.x = cvt_pk_bf16(v0[0], v0[1]); w.y = cvt_pk_bf16(v0[2], v0[3]); w.z = cvt_pk_bf16(v1[0], v1[1]); w.w = cvt_pk_bf16(v1[2], v1[3]);
                        *(u32x4*)(rowp + bj * 128) = w; } }
        } else {
            const int col0 = (u.pn & 1) * 256 + wc * 32 + 8 * fq;
            float* dst = out + (u.pn < 2 ? O_MK : O_MV); bf16_t* dstb = (u.pn < 2 ? MKB : MVB);
#pragma unroll
            for (int ai = 0; ai < 2; ++ai)
#pragma unroll
                for (int m = 0; m < 4; ++m) { const size_t off = (size_t)(row0 + ai * 128 + m * 16) * 512 + col0;
#pragma unroll
                    for (int bj = 0; bj < 2; ++bj) { const f32x4 v0 = acc[ai][bj][m][0], v1 = acc[ai][bj][m][1];
                        *(f32x4*)(dst + off + bj * 128) = v0; *(f32x4*)(dst + off + bj * 128 + 4) = v1;
                        u32x4 w; w.x = cvt_pk_bf16(v0[0], v0[1]); w.y = cvt_pk_bf16(v0[2], v0[3]); w.z = cvt_pk_bf16(v1[0], v1[1]); w.w = cvt_pk_bf16(v1[2], v1[3]);
                        *(u32x4*)(dstb + off + bj * 128) = w; } }
        }
    }
};
struct Prog3 {
    const char *BRANCH, *WO; const float *xp, *xs; float* out; int G, c;
    __device__ __forceinline__ bool next(int i, pg8::Unit& u) const {
        const int L = i * G + c; if (L >= 288) return false;
        pg8::static_tile(L, 36, 8, u.pm, u.pn); u.kind = 2; return true;
    }
    __device__ __forceinline__ const char* a_ptr(const pg8::Unit& u) const { return BRANCH + (size_t)u.pm * pg8::TSTEP; }
    __device__ __forceinline__ const char* b_ptr(const pg8::Unit& u) const { return WO + (size_t)u.pn * pg8::TSTEP; }
    __device__ __forceinline__ void epi(const pg8::Acc& acc, const pg8::Unit& u, int wr, int wc, int fr, int fq) const {
        const int row0 = u.pm * 256 + wr * 64 + fr; const int col0 = u.pn * 256 + wc * 32 + 8 * fq;
        const float* xb = (u.pm < 32) ? xp : (xs - (size_t)NP * DM);
#pragma unroll
        for (int ai = 0; ai < 2; ++ai)
#pragma unroll
            for (int m = 0; m < 4; ++m) { const size_t off = (size_t)(row0 + ai * 128 + m * 16) * DM + col0;
#pragma unroll
                for (int bj = 0; bj < 2; ++bj) { const f32x4 x0 = *(const f32x4*)(xb + off + bj * 128), x1 = *(const f32x4*)(xb + off + bj * 128 + 4);
                    *(f32x4*)(out + off + bj * 128) = acc[ai][bj][m][0] + x0; *(f32x4*)(out + off + bj * 128 + 4) = acc[ai][bj][m][1] + x1; } }
    }
};

__device__ __forceinline__ void norm_row_to_bf16(const float* src, const float* w, bf16_t* dst, int lane) {
    const f32x4* s = (const f32x4*)src + lane; const f32x4* wv = (const f32x4*)w + lane;
    f32x4 v[8]; float ss = 0.f;
#pragma unroll
    for (int j = 0; j < 8; ++j) { v[j] = s[64 * j]; ss += (v[j].x * v[j].x + v[j].y * v[j].y) + (v[j].z * v[j].z + v[j].w * v[j].w); }
    const float rstd = 1.0f / sqrtf(wave_sum(ss) * (1.0f / DM) + EPS);
    u32x2* o = (u32x2*)dst + lane;
#pragma unroll
    for (int j = 0; j < 8; ++j) { const f32x4 ww = wv[64 * j]; u32x2 r; r.x = pk2(v[j].x * rstd * ww.x, v[j].y * rstd * ww.y); r.y = pk2(v[j].z * rstd * ww.z, v[j].w * rstd * ww.w); o[64 * j] = r; }
}
__device__ __forceinline__ void transpose_item(const float* W, int ldw, int csrc, bf16_t* WT, int n0, int k0, LAS float* scr, int lane) {
#pragma unroll 8
    for (int i = 0; i < 32; ++i) { const int kk = 2 * i + (lane >> 5); scr[kk * 33 + (lane & 31)] = W[(size_t)(k0 + kk) * ldw + csrc + (lane & 31)]; }
    asm volatile("s_waitcnt lgkmcnt(0)" ::: "memory");
    const int c = lane & 7;
#pragma unroll
    for (int j = 0; j < 4; ++j) { const int n = (lane >> 3) + 8 * j; const LAS float* s = scr + (8 * c) * 33 + n;
        u32x4 o; o.x = pk2(s[0 * 33], s[1 * 33]); o.y = pk2(s[2 * 33], s[3 * 33]); o.z = pk2(s[4 * 33], s[5 * 33]); o.w = pk2(s[6 * 33], s[7 * 33]);
        *(u32x4*)(WT + (size_t)(n0 + n) * DM + k0 + 8 * c) = o; }
    asm volatile("s_waitcnt lgkmcnt(0)" ::: "memory");
}
__device__ __forceinline__ void phase_prep(const Params& p, LAS unsigned char* lds) {
    const int tid = threadIdx.x, lane = tid & 63, wave = tid >> 6;
    const int gw = blockIdx.x * 8 + wave, NGW = gridDim.x * 8;
    unsigned char* ws = p.ws;
    bf16_t* XB = (bf16_t*)(ws + WS_XB); bf16_t* MB = (bf16_t*)(ws + WS_MB);
    for (int r = gw; r < NTOK + NMR; r += NGW) {
        if (r < NP) norm_row_to_bf16(p.x_prompt + (size_t)r * DM, p.norm_w, XB + (size_t)r * DM, lane);
        else if (r < NTOK) norm_row_to_bf16(p.x_sample + (size_t)(r - NP) * DM, p.norm_w, XB + (size_t)r * DM, lane);
        else norm_row_to_bf16(p.mem + (size_t)(r - NTOK) * DM, p.mem_norm_w, MB + (size_t)(r - NTOK) * DM, lane);
    }
    LAS float* scr = (LAS float*)(lds + wave * 8704);
    constexpr int I_IN = 32 * (DINP / 32), I_M = 32 * (1024 / 32), I_O = 32 * (2048 / 32);
    bf16_t* WIN = (bf16_t*)(ws + WS_WIN); bf16_t* WM = (bf16_t*)(ws + WS_WM); bf16_t* WO = (bf16_t*)(ws + WS_WO); bf16_t* WR = (bf16_t*)(ws + WS_WR);
    for (int it = gw; it < I_IN + I_M + I_O; it += NGW) {
        int r = it;
        if (r < I_IN) { const int nb = r % (DINP / 32), kb = r / (DINP / 32), n0 = nb * 32; transpose_item(p.w_in, DIN, n0 + (n0 >= SRC_BR ? 16 : 0), WIN, n0, kb * 64, scr, lane); continue; }
        r -= I_IN;
        if (r < I_M) { const int nb = r % 32, kb = r / 32; transpose_item(p.w_mem, 1024, nb * 32, WM, nb * 32, kb * 64, scr, lane); continue; }
        r -= I_M;
        { const int nb = r % 64, kb = r / 64; transpose_item(p.w_out, 2048, nb * 32, WO, nb * 32, kb * 64, scr, lane); }
    }
    for (int i = blockIdx.x * NTHREADS + tid; i < 16 * DM; i += gridDim.x * NTHREADS) { const int r = i & 15, k = i >> 4; WR[r * DM + k] = (bf16_t)f2bf(p.w_in[(size_t)k * DIN + SRC_BR + r]); }
}

__device__ __forceinline__ void br_task(const bf16_t* XB, const bf16_t* WR, float* BR, int task, int wave, int lane) {
    const int fr = lane & 15, fq = lane >> 4, row0 = task * 128 + wave * 16;
    const bf16_t* ap = XB + (size_t)(row0 + fr) * DM + 8 * fq; const bf16_t* bp = WR + (size_t)fr * DM + 8 * fq;
    f32x4 acc = (f32x4){0.f, 0.f, 0.f, 0.f};
#pragma unroll 8
    for (int k0 = 0; k0 < DM; k0 += 32) { const bf16x8 a = *(const bf16x8*)(ap + k0), b = *(const bf16x8*)(bp + k0); acc = __builtin_amdgcn_mfma_f32_16x16x32_bf16(a, b, acc, 0, 0, 0); }
#pragma unroll
    for (int j = 0; j < 4; ++j) BR[(size_t)(row0 + 4 * fq + j) * 16 + fr] = acc[j];
}

__device__ __forceinline__ void mixA_task(const Params& p, LAS unsigned char* lds, int row0, int h, int L, bool write_cv) {
    const int tid = threadIdx.x, lane = tid & 63, wave = tid >> 6;
    const bf16_t* PROJ = (const bf16_t*)(p.ws + WS_PROJ); bf16_t* BRANCH = (bf16_t*)(p.ws + WS_BRANCH);
    LAS float* Wl = (LAS float*)lds;
    LAS bf16_t* vn = (LAS bf16_t*)(lds + 65536);
    LAS float* rs = (LAS float*)(lds + 65536 + 49152);
    __syncthreads();
    for (int t = wave * 16; t < wave * 16 + 16; ++t) {
        const u32x2* src = (const u32x2*)(PROJ + (size_t)(row0 + t) * DINP + C_AV) + lane; float ss = 0.f;
#pragma unroll
        for (int j = 0; j < 3; ++j) { const u32x2 w = src[64 * j]; const float a = bflo(w.x), b = bfhi(w.x), c = bflo(w.y), d = bfhi(w.y); ss += (a * a + b * b) + (c * c + d * d); }
        ss = wave_sum(ss);
        if (lane == 0) rs[t] = 1.0f / sqrtf(ss * (1.0f / 768.0f) + EPS);
    }
    for (int i = tid; i < 128 * 32; i += NTHREADS) ((LAS f32x4*)Wl)[i] = ((const f32x4*)(p.a_ws + (size_t)h * 16384))[i];
    __syncthreads();
    for (int i = tid; i < 128 * 192; i += NTHREADS) { const int t = i / 192, dd = i % 192;
        const float v = bf2f(PROJ[(size_t)(row0 + t) * DINP + C_AV + h * 192 + dd]) * rs[t] * p.a_vnorm_w[h * 192 + dd];
        vn[i] = (bf16_t)f2bf(v);
        if (write_cv) p.out[O_CV + (size_t)(row0 - NP + t) * 768 + h * 192 + dd] = v; }
    __syncthreads();
    if (tid < 384) {
        const int dd2 = tid % 96, ig = tid / 96;
        for (int k = 0; k < 32; ++k) {
            const int rl = ig + 4 * k, i = rl % L, cs = rl - i;
            float a0 = 0.f, a1 = 0.f;
            for (int j = 0; j <= i; ++j) { const float w = Wl[i * 128 + j]; const unsigned v = *(const LAS unsigned*)(vn + (cs + j) * 192 + 2 * dd2); a0 += w * bflo(v); a1 += w * bfhi(v); }
            const float bsv = p.a_bs[h * 128 + i]; a0 += bsv; a1 += bsv;
            const size_t rb = (size_t)(row0 + rl) * DINP + h * 192 + 2 * dd2;
            const unsigned uu = *(const unsigned*)(PROJ + rb + C_AU), gg = *(const unsigned*)(PROJ + rb + C_AG);
            const float o0 = bflo(uu) * a0 * silu(bflo(gg)), o1 = bfhi(uu) * a1 * silu(bfhi(gg));
            *(unsigned*)(BRANCH + (size_t)(row0 + rl) * DM + h * 192 + 2 * dd2) = pk2(o0, o1);
        }
    }
}

template <bool F32SRC>
__device__ __forceinline__ void mixX_task(const Params& p, LAS unsigned char* lds, const void* Ksrc, const void* Vsrc, int kvrow0, int h, int qrow0, int nq) {
    const int tid = threadIdx.x, lane = tid & 63, wave = tid >> 6;
    const bf16_t* PROJ = (const bf16_t*)(p.ws + WS_PROJ); bf16_t* BRANCH = (bf16_t*)(p.ws + WS_BRANCH);
    LAS unsigned char* Kl = lds;
    LAS unsigned char* Vl = lds + 69632;
    LAS float* qs = (LAS float*)(lds + 69632 + 65536) + wave * 128;
    LAS float* ps = (LAS float*)(lds + 69632 + 65536 + 4096) + wave * 256;
    __syncthreads();
    if (F32SRC) {
        const float* K = (const float*)Ksrc; const float* V = (const float*)Vsrc;
        for (int i = tid; i < 256 * 32; i += NTHREADS) { const int n = i >> 5, ch = i & 31; const size_t g = (size_t)(kvrow0 + n) * 512 + h * 128 + ch * 4;
            const f32x4 kv = *(const f32x4*)(K + g), vv = *(const f32x4*)(V + g);
            u32x2 a; a.x = pk2(kv.x, kv.y); a.y = pk2(kv.z, kv.w); *(LAS u32x2*)(Kl + n * 272 + ch * 8) = a;
            u32x2 b; b.x = pk2(vv.x, vv.y); b.y = pk2(vv.z, vv.w); *(LAS u32x2*)(Vl + n * 256 + ch * 8) = b; }
    } else {
        const bf16_t* K = (const bf16_t*)Ksrc; const bf16_t* V = (const bf16_t*)Vsrc;
        for (int i = tid; i < 256 * 16; i += NTHREADS) { const int n = i >> 4, ch = i & 15; const size_t g = (size_t)(kvrow0 + n) * 512 + h * 128 + ch * 8;
            *(LAS u32x4*)(Kl + n * 272 + ch * 16) = *(const u32x4*)(K + g); *(LAS u32x4*)(Vl + n * 256 + ch * 16) = *(const u32x4*)(V + g); }
    }
    __syncthreads();
    for (int qi = wave; qi < nq; qi += 8) {
        const int row = qrow0 + qi;
        { const unsigned w = *(const unsigned*)(PROJ + (size_t)row * DINP + C_XQ + h * 128 + 2 * lane); qs[2 * lane] = bflo(w) * 0.08838834764831845f; qs[2 * lane + 1] = bfhi(w) * 0.08838834764831845f; }
        asm volatile("s_waitcnt lgkmcnt(0)" ::: "memory");
        float s[4] = {0.f, 0.f, 0.f, 0.f};
        for (int c = 0; c < 16; ++c) {
            const f32x4 qa = *(const LAS f32x4*)(qs + 8 * c), qb = *(const LAS f32x4*)(qs + 8 * c + 4);
#pragma unroll
            for (int kk = 0; kk < 4; ++kk) { const u32x4 kv = *(const LAS u32x4*)(Kl + (lane + 64 * kk) * 272 + c * 16);
                s[kk] += (qa.x * bflo(kv.x) + qa.y * bfhi(kv.x)) + (qa.z * bflo(kv.y) + qa.w * bfhi(kv.y)) + (qb.x * bflo(kv.z) + qb.y * bfhi(kv.z)) + (qb.z * bflo(kv.w) + qb.w * bfhi(kv.w)); }
        }
        const float mx = wave_max(fmaxf(fmaxf(s[0], s[1]), fmaxf(s[2], s[3])));
        float e[4], sum = 0.f;
#pragma unroll
        for (int kk = 0; kk < 4; ++kk) { e[kk] = __expf(s[kk] - mx); sum += e[kk]; }
        const float inv = 1.0f / wave_sum(sum);
#pragma unroll
        for (int kk = 0; kk < 4; ++kk) ps[lane + 64 * kk] = e[kk] * inv;
        asm volatile("s_waitcnt lgkmcnt(0)" ::: "memory");
        float o0 = 0.f, o1 = 0.f;
        for (int n = 0; n < 256; n += 4) { const f32x4 pp = *(const LAS f32x4*)(ps + n);
#pragma unroll
            for (int j = 0; j < 4; ++j) { const unsigned v = *(const LAS unsigned*)(Vl + (n + j) * 256 + lane * 4); o0 += pp[j] * bflo(v); o1 += pp[j] * bfhi(v); } }
        const unsigned g = *(const unsigned*)(PROJ + (size_t)row * DINP + C_XG + h * 128 + 2 * lane);
        *(unsigned*)(BRANCH + (size_t)row * DM + 1536 + h * 128 + 2 * lane) = pk2(o0 * silu(bflo(g)), o1 * silu(bfhi(g)));
    }
}

__device__ __forceinline__ void mixB_task(const Params& p, LAS unsigned char* lds, int row0, int T, int h, const float* s0, float* sout) {
    const int tid = threadIdx.x, lane = tid & 63, wave = tid >> 6;
    const bf16_t* PROJ = (const bf16_t*)(p.ws + WS_PROJ); bf16_t* BRANCH = (bf16_t*)(p.ws + WS_BRANCH); const float* BR = (const float*)(p.ws + WS_BR);
    LAS float* qs = (LAS float*)lds;
    LAS float* ks = qs + 32 * 96;
    LAS float* al = ks + 32 * 96;
    LAS float* vs = al + 32 * 96;
    LAS float* po = vs + 32 * 192;
    const int e = tid % 192, hf = tid / 192, d0 = hf * 48;
    float S[48];
#pragma unroll
    for (int dd = 0; dd < 48; ++dd) S[dd] = (s0 && tid < 384) ? s0[(size_t)(d0 + dd) * 192 + e] : 0.f;
    const int TC = T < 32 ? T : 32;
    for (int t0 = 0; t0 < T; t0 += TC) {
        __syncthreads();
        for (int i = tid; i < TC * 96; i += NTHREADS) { const int t = i / 96, d = i % 96; const size_t row = (size_t)(row0 + t0 + t);
            float z = p.b_ba[h * 96 + d];
#pragma unroll
            for (int r = 0; r < 16; ++r) z += BR[row * 16 + r] * p.b_wa[r * 384 + h * 96 + d];
            const float la = (fminf(z, 0.f) - log1pf(__expf(-fabsf(z)))) * (1.0f / 16.0f);
            al[i] = __expf(la);
            qs[i] = bf2f(PROJ[row * DINP + C_BQ + h * 96 + d]) * 0.10206207261596577f;
            ks[i] = bf2f(PROJ[row * DINP + C_BK + h * 96 + d]); }
        for (int i = tid; i < TC * 192; i += NTHREADS) { const int t = i / 192, ee = i % 192; vs[i] = bf2f(PROJ[(size_t)(row0 + t0 + t) * DINP + C_BV + h * 192 + ee]); }
        __syncthreads();
        if (tid < 384) {
#pragma unroll 1
            for (int t = 0; t < TC; ++t) {
                const float v = vs[t * 192 + e]; float acc = 0.f;
#pragma unroll
                for (int d4 = 0; d4 < 12; ++d4) {
                    const f32x4 a4 = *(const LAS f32x4*)(al + t * 96 + d0 + 4 * d4), k4 = *(const LAS f32x4*)(ks + t * 96 + d0 + 4 * d4), q4 = *(const LAS f32x4*)(qs + t * 96 + d0 + 4 * d4);
#pragma unroll
                    for (int j = 0; j < 4; ++j) { S[4 * d4 + j] = a4[j] * S[4 * d4 + j] + k4[j] * v; acc += q4[j] * S[4 * d4 + j]; }
                    if ((d4 % 3) == 2) asm volatile("" ::: "memory");
                }
                po[(hf * 32 + t) * 192 + e] = acc;
            }
        }
        __syncthreads();
        for (int t = wave; t < TC; t += 8) {
            const size_t row = (size_t)(row0 + t0 + t);
            float o[3], ss = 0.f;
#pragma unroll
            for (int j = 0; j < 3; ++j) { o[j] = po[t * 192 + lane + 64 * j] + po[(32 + t) * 192 + lane + 64 * j]; ss += o[j] * o[j]; }
            const float rstd = 1.0f / sqrtf(wave_sum(ss) * (1.0f / 192.0f) + EPS);
#pragma unroll
            for (int j = 0; j < 3; ++j) { const int ee = lane + 64 * j; const float g = bf2f(PROJ[row * DINP + C_BG + h * 192 + ee]);
                BRANCH[row * DM + 768 + h * 192 + ee] = (bf16_t)f2bf(o[j] * rstd * p.b_onorm_w[ee] * silu(g)); }
        }
    }
    if (tid < 384) {
#pragma unroll
        for (int dd = 0; dd < 48; ++dd) sout[(size_t)(d0 + dd) * 192 + e] = S[dd];
    }
}

__device__ __forceinline__ void phase_mix(const Params& p, LAS unsigned char* lds) {
    const int G = gridDim.x, c = blockIdx.x;
    const int NBP = 16, NBS = 512, NA = 256 + 32, NXP = 256, NXS = 512, NTASK = NBP + NBS + NA + NXP + NXS;
    for (int t = c; t < NTASK; t += G) {
        int r = t;
        if (r < NBP + NBS) {
            int row0, T, h; const float* s0; float* so;
            if (r < NBP) { const int b = r >> 2; h = r & 3; row0 = b * SEQ; T = SEQ; s0 = nullptr; so = p.out + O_SP + (size_t)(b * 4 + h) * 96 * 192; }
            else { const int q = r - NBP, b = q >> 2; h = q & 3; row0 = NP + b * 8; T = 8; s0 = p.state + (size_t)(b * 4 + h) * 96 * 192; so = p.out + O_SS + (size_t)(b * 4 + h) * 96 * 192; }
            mixB_task(p, lds, row0, T, h, s0, so); continue; }
        r -= NBP + NBS;
        if (r < NA) { const int h = r & 3, blk = r >> 2; const bool smp = r >= 256; mixA_task(p, lds, smp ? NP + (blk - 64) * 128 : blk * 128, h, smp ? 8 : 128, smp); continue; }
        r -= NA;
        if (r < NXP) { const int qt = r & 15, h = (r >> 4) & 3, b = r >> 6; mixX_task<false>(p, lds, p.ws + WS_MKB, p.ws + WS_MVB, b * 256, h, b * SEQ + qt * 128, 128); continue; }
        r -= NXP;
        { const int h = r & 3, b = r >> 2; mixX_task<true>(p, lds, p.cache_k, p.cache_v, b * 256, h, NP + b * 8, 8); }
    }
}

__device__ __forceinline__ void phase_final(const Params& p) {
    const int lane = threadIdx.x & 63, wave = threadIdx.x >> 6;
    const int gw = blockIdx.x * 8 + wave, NGW = gridDim.x * 8;
    for (int r = gw; r < NTOK; r += NGW) {
        f32x4* s = (f32x4*)(p.out + (size_t)r * DM) + lane; const f32x4* wv = (const f32x4*)p.final_w + lane;
        f32x4 v[8]; float ss = 0.f;
#pragma unroll
        for (int j = 0; j < 8; ++j) { v[j] = s[64 * j]; ss += (v[j].x * v[j].x + v[j].y * v[j].y) + (v[j].z * v[j].z + v[j].w * v[j].w); }
        const float rstd = 1.0f / sqrtf(wave_sum(ss) * (1.0f / DM) + EPS);
#pragma unroll
        for (int j = 0; j < 8; ++j) { const f32x4 ww = wv[64 * j]; s[64 * j] = v[j] * rstd * ww; }
    }
}

__global__ void __launch_bounds__(NTHREADS, 2) fwd(Params p) {
    extern __shared__ __attribute__((aligned(16))) unsigned char lds_raw[];
    LAS unsigned char* lds = (LAS unsigned char*)lds_raw;
    const int lo = p.ph_lo, hi = p.ph_hi;
#ifndef PH_MASK
#define PH_MASK 31
#endif
#define IN(k) (((PH_MASK >> (k)) & 1) && lo <= (k) && (k) < hi)
    if (IN(0)) phase_prep(p, lds);
    if (IN(1)) {
        Prog1 P; P.XB = (const char*)(p.ws + WS_XB); P.WIN = (const char*)(p.ws + WS_WIN); P.MB = (const char*)(p.ws + WS_MB); P.WM = (const char*)(p.ws + WS_WM);
        P.PROJ = (bf16_t*)(p.ws + WS_PROJ); P.out = p.out; P.MKB = (bf16_t*)(p.ws + WS_MKB); P.MVB = (bf16_t*)(p.ws + WS_MVB); P.G = gridDim.x; P.c = blockIdx.x;
        pg8::gemm_phase(lds, P);
        const int wave = threadIdx.x >> 6, lane = threadIdx.x & 63;
        for (int t = (blockIdx.x + gridDim.x - 40) % gridDim.x; t < 72; t += gridDim.x) br_task((const bf16_t*)(p.ws + WS_XB), (const bf16_t*)(p.ws + WS_WR), (float*)(p.ws + WS_BR), t, wave, lane);
    }
    if (IN(2)) phase_mix(p, lds);
    if (IN(3)) {
        Prog3 P; P.BRANCH = (const char*)(p.ws + WS_BRANCH); P.WO = (const char*)(p.ws + WS_WO); P.xp = p.x_prompt; P.xs = p.x_sample; P.out = p.out; P.G = gridDim.x; P.c = blockIdx.x;
        pg8::gemm_phase(lds, P);
    }
    if (IN(4)) phase_final(p);
#undef IN
}

extern "C" void kernel_launch(void* const* d_in, const int* in_sizes, int n_in, void* d_out, int out_size, void* d_ws, size_t ws_size, hipStream_t stream) {
    static int grid = 0;
    if (grid == 0) {
        if (n_in != 18 || ws_size < WS_END) { fprintf(stderr, "kernel_launch: unexpected n_in %d or ws_size %zu\n", n_in, ws_size); grid = -1; return; }
        int dev = 0, cus = 0;
        if (hipGetDevice(&dev) != hipSuccess || hipDeviceGetAttribute(&cus, hipDeviceAttributeMultiprocessorCount, dev) != hipSuccess) { grid = -1; return; }
        if (hipFuncSetAttribute((const void*)fwd, hipFuncAttributeMaxDynamicSharedMemorySize, LDS_BYTES) != hipSuccess) { fprintf(stderr, "kernel_launch: hipFuncSetAttribute failed\n"); grid = -1; return; }
        grid = cus > 0 ? cus : 256;
    }
    if (grid < 0) return;
    Params p{};
    const float** pp = (const float**)&p;
    for (int i = 0; i < 18; ++i) pp[i] = (const float*)d_in[i];
    p.out = (float*)d_out; p.ws = (unsigned char*)d_ws;
    (void)hipMemsetAsync((char*)d_ws + WS_CTL, 0, CTL_BYTES, stream);
    for (int ph = 0; ph < 5; ++ph) { p.ph_lo = ph; p.ph_hi = ph + 1; hipLaunchKernelGGL(fwd, dim3(grid), dim3(NTHREADS), LDS_BYTES, stream, p); }
}
```

```cpp
#include <hip/hip_runtime.h>
#include <cstdio>
#include <cstdint>

#define LAS __attribute__((address_space(3)))
typedef unsigned short bf16_t;
typedef short bf16x8 __attribute__((ext_vector_type(8)));
typedef float f32x4 __attribute__((ext_vector_type(4)));
typedef float f32x2 __attribute__((ext_vector_type(2)));
typedef unsigned u32x4 __attribute__((ext_vector_type(4)));
typedef unsigned u32x2 __attribute__((ext_vector_type(2)));

#ifndef N_LAUNCH_MODE
#define N_LAUNCH_MODE 1
#endif

constexpr int DM = 2048;
constexpr int NP = 8192, NS = 1024, NTOK = NP + NS, NMR = 1024;
constexpr int SEQ = 2048, DSEQ = 8, NB = 4, DB = 128, NMEM = 256;
constexpr int DIN = 5648, DINP = 5632;
constexpr int C_AU = 0, C_AV = 768, C_AG = 1536, C_BQ = 2304, C_BK = 2688, C_BV = 3072, C_BG = 3840, C_XQ = 4608, C_XG = 5120;
constexpr int SRC_BR = 3840;
constexpr float EPS = 1e-6f;
constexpr size_t O_Y = 0, O_MK = 18874368, O_MV = 19398656, O_SP = 19922944, O_SS = 20217856, O_CV = 29655040;
constexpr size_t MiB = 1u << 20;
constexpr size_t WS_CTL = 0, CTL_BYTES = 1 * MiB;
constexpr size_t WS_XB = 2 * MiB, WS_MB = 38 * MiB, WS_WIN = 42 * MiB, WS_WM = 64 * MiB, WS_WO = 68 * MiB, WS_WR = 76 * MiB, WS_BR = 77 * MiB,
                 WS_MKB = 78 * MiB, WS_MVB = 79 * MiB, WS_PROJ = 80 * MiB, WS_BRANCH = 180 * MiB, WS_END = 216 * MiB;
constexpr int LDS_MISC = 147456;
constexpr int LDS_BYTES = 148480;
constexpr int NTHREADS = 512;

struct Params {
    const float *x_prompt, *x_sample, *mem, *state, *cache_k, *cache_v, *norm_w, *w_in, *a_vnorm_w, *a_ws, *a_bs, *b_wa, *b_ba, *b_onorm_w,
                *mem_norm_w, *w_mem, *w_out, *final_w;
    float* out; unsigned char* ws;
    int ph_lo, ph_hi;
};

__device__ __forceinline__ unsigned f2bf(float f) { unsigned u = __builtin_bit_cast(unsigned, f); return (u + 0x7fffu + ((u >> 16) & 1u)) >> 16; }
__device__ __forceinline__ unsigned pk2(float lo, float hi) { return f2bf(lo) | (f2bf(hi) << 16); }
__device__ __forceinline__ float bflo(unsigned w) { return __builtin_bit_cast(float, w << 16); }
__device__ __forceinline__ float bfhi(unsigned w) { return __builtin_bit_cast(float, w & 0xffff0000u); }
__device__ __forceinline__ float bf2f(bf16_t b) { return __builtin_bit_cast(float, ((unsigned)b) << 16); }
__device__ __forceinline__ unsigned cvt_pk_bf16(float lo, float hi) { unsigned r; asm volatile("v_cvt_pk_bf16_f32 %0, %1, %2" : "=v"(r) : "v"(lo), "v"(hi)); return r; }
__device__ __forceinline__ float wave_sum(float v) {
#pragma unroll
    for (int o = 1; o < 64; o <<= 1) v += __shfl_xor(v, o);
    return v;
}
__device__ __forceinline__ float wave_max(float v) {
#pragma unroll
    for (int o = 1; o < 64; o <<= 1) v = fmaxf(v, __shfl_xor(v, o));
    return v;
}
__device__ __forceinline__ float silu(float x) { return x / (1.0f + __expf(-x)); }

namespace pg8 {
constexpr int BM = 256, BK = 64, HALF = 128, HTB = HALF * BK * 2, STAGE_BYTES = 8 * HTB, NXCD = 8, WGM = 8;
constexpr int K = DM, NT = K / BK;
constexpr size_t TSTEP = (size_t)BM * K * 2;
__device__ __forceinline__ int lds_byte(int r, int c) { const int st = (r >> 4) * 2 + (c >> 5), rr = r & 15, cc = c & 31, ob = rr * 64 + cc * 2; return st * 1024 + (ob ^ (((ob >> 9) & 1) << 5)); }
__device__ __forceinline__ void stage_rc(int b, int& R, int& C) { const int st = b / 1024, sb = b % 1024, swz = sb ^ (((sb >> 9) & 1) << 5); R = (st >> 1) * 16 + swz / 64; C = (st & 1) * 32 + (swz % 64) / 2; }
__device__ __forceinline__ int perm32(int rho) { const int n = rho >> 4, i = rho & 15; return 8 * (i >> 2) + 4 * n + (i & 3); }
struct Unit { int pm, pn, kind; };
__device__ __forceinline__ void static_tile(int L, int nM, int nN, int& pm, int& pn) {
    const int nwg = nM * nN; int wgid = L; { const int q = nwg / NXCD, r = nwg % NXCD, xcd = wgid % NXCD, off = wgid / NXCD; wgid = (xcd < r ? xcd * (q + 1) : r * (q + 1) + (xcd - r) * q) + off; }
    const int nig = WGM * nN, gid = wgid / nig, fm = gid * WGM, gsz = (nM - fm) < WGM ? (nM - fm) : WGM;
    pm = fm + ((wgid % nig) % gsz); pn = (wgid % nig) / gsz;
}
typedef f32x4 Acc[2][2][4][2];

template <class Prog>
__device__ __forceinline__ void gemm_phase(LAS unsigned char* lds, const Prog& P) {
    const int tid = threadIdx.x, wid = __builtin_amdgcn_readfirstlane(tid >> 6), lane = tid & 63, wr = wid >> 2, wc = wid & 3, fr = lane & 15, fq = lane >> 4;
    unsigned voffA[2], voffB[2];
#pragma unroll
    for (int i = 0; i < 2; ++i) { int R, C; stage_rc(tid * 16 + i * 8192, R, C); const int Rb = (R & ~31) + perm32(R & 31);
        voffA[i] = (unsigned)(R * K + C) * 2u; voffB[i] = (unsigned)(Rb * K + C) * 2u; }
    const size_t kstep = (size_t)(BK * 2);
    const size_t hstep = (size_t)HALF * K * 2;
    const unsigned ldsw = (unsigned)wid * 1024u;
    const int aoff = lds_byte(wr * 64 + fr, fq * 8), boff = lds_byte(wc * 32 + fr, fq * 8);
#define PG8_SA(b, h) (((b) * 2 + (h)) * HTB)
#define PG8_SB(b, h) ((4 + (b) * 2 + (h)) * HTB)
#define PG8_STAGE(bufoff, gbase, voff) do { _Pragma("unroll") for (int _i = 0; _i < 2; ++_i) \
        __builtin_amdgcn_global_load_lds((const unsigned*)((const char*)(gbase) + (voff)[_i]), (LAS unsigned*)(lds + (bufoff) + ldsw + _i * 8192), 16, 0, 0); } while (0)
#define PG8_LDA(dst, b, h) do { _Pragma("unroll") for (int m = 0; m < 4; ++m) _Pragma("unroll") for (int k = 0; k < 2; ++k) dst[m][k] = *(const LAS bf16x8*)(lds + PG8_SA(b, h) + aoff + m * 2048 + k * 1024); } while (0)
#define PG8_LDB(dst, b, h) do { _Pragma("unroll") for (int n = 0; n < 2; ++n) _Pragma("unroll") for (int k = 0; k < 2; ++k) dst[n][k] = *(const LAS bf16x8*)(lds + PG8_SB(b, h) + boff + n * 2048 + k * 1024); } while (0)
#define PG8_MMA(ai, bj, At, Bt) do { __builtin_amdgcn_s_setprio(1); _Pragma("unroll") for (int m = 0; m < 4; ++m) _Pragma("unroll") for (int n = 0; n < 2; ++n) _Pragma("unroll") for (int k = 0; k < 2; ++k) \
        acc[ai][bj][m][n] = __builtin_amdgcn_mfma_f32_16x16x32_bf16(Bt[n][k], At[m][k], acc[ai][bj][m][n], 0, 0, 0); __builtin_amdgcn_s_setprio(0); } while (0)
#define PG8_WAIT_V(n) asm volatile("s_waitcnt vmcnt(" #n ")" ::: "memory")
#define PG8_WAIT_L(n) asm volatile("s_waitcnt lgkmcnt(" #n ")" ::: "memory")
#define PG8_BAR __builtin_amdgcn_s_barrier()
#define PG8_SCHED __builtin_amdgcn_sched_barrier(0)
    Unit cur, nxt; int ui = 0;
    if (!P.next(0, cur)) return;
    Acc acc;
#pragma unroll
    for (int a = 0; a < 2; ++a)
#pragma unroll
        for (int b = 0; b < 2; ++b)
#pragma unroll
            for (int m = 0; m < 4; ++m)
#pragma unroll
                for (int n = 0; n < 2; ++n) acc[a][b][m][n] = (f32x4){0.f, 0.f, 0.f, 0.f};
    bf16x8 At[4][2], B0[2][2], B1[2][2];
    const char* cA = P.a_ptr(cur); const char* cB = P.b_ptr(cur);
    PG8_STAGE(PG8_SB(0, 0), cB, voffB); PG8_STAGE(PG8_SA(0, 0), cA, voffA); PG8_STAGE(PG8_SB(0, 1), cB + hstep, voffB); PG8_STAGE(PG8_SA(0, 1), cA + hstep, voffA);
    if (wr == 1) PG8_BAR;
    PG8_WAIT_V(4); PG8_BAR;
    PG8_STAGE(PG8_SB(1, 0), cB + kstep, voffB); PG8_STAGE(PG8_SA(1, 0), cA + kstep, voffA); PG8_STAGE(PG8_SB(1, 1), cB + hstep + kstep, voffB);
    PG8_WAIT_V(6); PG8_BAR;
    for (;;) {
        const bool has_next = P.next(ui + 1, nxt);
        const char* nA = has_next ? P.a_ptr(nxt) : cA; const char* nB = has_next ? P.b_ptr(nxt) : cB;
        for (int t = 0; t < NT; t += 2) {
            const bool last = (t == NT - 2);
            const char* a1 = cA + (size_t)(t + 1) * kstep;
            const char* a2 = last ? nA : cA + (size_t)(t + 2) * kstep; const char* b2 = last ? nB : cB + (size_t)(t + 2) * kstep;
            const char* a3 = a2 + kstep; const char* b3 = b2 + kstep;
            PG8_LDB(B0, 0, 0); PG8_SCHED; PG8_LDA(At, 0, 0); PG8_STAGE(PG8_SA(1, 1), a1 + hstep, voffA);
            PG8_WAIT_L(8); PG8_BAR; PG8_WAIT_L(0); PG8_MMA(0, 0, At, B0); PG8_BAR; PG8_SCHED;
            PG8_LDB(B1, 0, 1); PG8_STAGE(PG8_SB(0, 0), b2, voffB);
            PG8_BAR; PG8_WAIT_L(0); PG8_MMA(0, 1, At, B1); PG8_BAR;
            PG8_LDA(At, 0, 1); PG8_STAGE(PG8_SA(0, 0), a2, voffA);
            PG8_BAR; PG8_WAIT_L(0); PG8_MMA(1, 0, At, B0); PG8_BAR; PG8_SCHED;
            PG8_STAGE(PG8_SB(0, 1), b2 + hstep, voffB);
            PG8_WAIT_V(6); PG8_BAR; PG8_MMA(1, 1, At, B1); PG8_BAR;
            PG8_LDB(B0, 1, 0); PG8_SCHED; PG8_LDA(At, 1, 0); PG8_STAGE(PG8_SA(0, 1), a2 + hstep, voffA);
            PG8_WAIT_L(8); PG8_BAR; PG8_WAIT_L(0); PG8_MMA(0, 0, At, B0); PG8_BAR; PG8_SCHED;
            PG8_LDB(B1, 1, 1); PG8_STAGE(PG8_SB(1, 0), b3, voffB);
            PG8_BAR; PG8_WAIT_L(0); PG8_MMA(0, 1, At, B1); PG8_BAR;
            PG8_LDA(At, 1, 1); PG8_STAGE(PG8_SA(1, 0), a3, voffA);
            PG8_BAR; PG8_WAIT_L(0); PG8_MMA(1, 0, At, B0); PG8_BAR; PG8_SCHED;
            PG8_STAGE(PG8_SB(1, 1), b3 + hstep, voffB);
            PG8_WAIT_V(6); PG8_BAR; PG8_MMA(1, 1, At, B1); PG8_BAR;
        }
        P.epi(acc, cur, wr, wc, fr, fq);
        if (!has_next) break;
#pragma unroll
        for (int a = 0; a < 2; ++a)
#pragma unroll
            for (int b = 0; b < 2; ++b)
#pragma unroll
                for (int m = 0; m < 4; ++m)
#pragma unroll
                    for (int n = 0; n < 2; ++n) acc[a][b][m][n] = (f32x4){0.f, 0.f, 0.f, 0.f};
        cur = nxt; cA = nA; cB = nB; ++ui;
    }
    PG8_WAIT_V(0);
    if (wr == 0) PG8_BAR;
    PG8_BAR;
#undef PG8_SA
#undef PG8_SB
#undef PG8_STAGE
#undef PG8_LDA
#undef PG8_LDB
#undef PG8_MMA
#undef PG8_WAIT_V
#undef PG8_WAIT_L
#undef PG8_BAR
#undef PG8_SCHED
}
}

struct Prog1 {
    const char *XB, *WIN, *MB, *WM; bf16_t* PROJ; float* out; bf16_t *MKB, *MVB; int G, c;
    __device__ __forceinline__ bool next(int i, pg8::Unit& u) const {
        const int L = i * G + c; if (L >= 808) return false;
        if (L < 792) { pg8::static_tile(L, 36, 22, u.pm, u.pn); u.kind = 0; } else { const int r = L - 792; u.pm = r >> 2; u.pn = r & 3; u.kind = 1; }
        return true;
    }
    __device__ __forceinline__ const char* a_ptr(const pg8::Unit& u) const { return (u.kind == 0 ? XB : MB) + (size_t)u.pm * pg8::TSTEP; }
    __device__ __forceinline__ const char* b_ptr(const pg8::Unit& u) const { return (u.kind == 0 ? WIN : WM) + (size_t)u.pn * pg8::TSTEP; }
    __device__ __forceinline__ void epi(const pg8::Acc& acc, const pg8::Unit& u, int wr, int wc, int fr, int fq) const {
        const int row0 = u.pm * 256 + wr * 64 + fr;
        if (u.kind == 0) {
            const int col0 = u.pn * 256 + wc * 32 + 8 * fq;
#pragma unroll
            for (int ai = 0; ai < 2; ++ai)
#pragma unroll
                for (int m = 0; m < 4; ++m) { bf16_t* rowp = PROJ + (size_t)(row0 + ai * 128 + m * 16) * DINP + col0;
#pragma unroll
                    for (int bj = 0; bj < 2; ++bj) { const f32x4 v0 = acc[ai][bj][m][0], v1 = acc[ai][bj][m][1];
                        u32x4 w; w.x = cvt_pk_bf16(v0[0], v0[1]); w.y = cvt_pk_bf16(v0[2], v0[3]); w.z = cvt_pk_bf16(v1[0], v1[1]); w.w = cvt_pk_bf16(v1[2], v1[3]);
                        *(u32x4*)(rowp + bj * 128) = w; } }
        } else {
            const int col0 = (u.pn & 1) * 256 + wc * 32 + 8 * fq;
            float* dst = out + (u.pn < 2 ? O_MK : O_MV); bf16_t* dstb = (u.pn < 2 ? MKB : MVB);
#pragma unroll
            for (int ai = 0; ai < 2; ++ai)
#pragma unroll
                for (int m = 0; m < 4; ++m) { const size_t off = (size_t)(row0 + ai * 128 + m * 16) * 512 + col0;
#pragma unroll
                    for (int bj = 0; bj < 2; ++bj) { const f32x4 v0 = acc[ai][bj][m][0], v1 = acc[ai][bj][m][1];
                        *(f32x4*)(dst + off + bj * 128) = v0; *(f32x4*)(dst + off + bj * 128 + 4) = v1;
                        u32x4 w; w.x = cvt_pk_bf16(v0[0], v0[1]); w.y = cvt_pk_bf16(v0[2], v0[3]); w.z = cvt_pk_bf16(v1[0], v1[1]); w.w = cvt_pk_bf16(v1[2], v1[3]);
                        *(u32x4*)(dstb + off + bj * 128) = w; } }
        }
    }
};
struct Prog3 {
    const char *BRANCH, *WO; const float *xp, *xs; float* out; int G, c;
    __device__ __forceinline__ bool next(int i, pg8::Unit& u) const {
        const int L = i * G + c; if (L >= 288) return false;
        pg8::static_tile(L, 36, 8, u.pm, u.pn); u.kind = 2; return true;
    }
    __device__ __forceinline__ const char* a_ptr(const pg8::Unit& u) const { return BRANCH + (size_t)u.pm * pg8::TSTEP; }
    __device__ __forceinline__ const char* b_ptr(const pg8::Unit& u) const { return WO + (size_t)u.pn * pg8::TSTEP; }
    __device__ __forceinline__ void epi(const pg8::Acc& acc, const pg8::Unit& u, int wr, int wc, int fr, int fq) const {
        const int row0 = u.pm * 256 + wr * 64 + fr; const int col0 = u.pn * 256 + wc * 32 + 8 * fq;
        const float* xb = (u.pm < 32) ? xp : (xs - (size_t)NP * DM);
#pragma unroll
        for (int ai = 0; ai < 2; ++ai)
#pragma unroll
            for (int m = 0; m < 4; ++m) { const size_t off = (size_t)(row0 + ai * 128 + m * 16) * DM + col0;
#pragma unroll
                for (int bj = 0; bj < 2; ++bj) { const f32x4 x0 = *(const f32x4*)(xb + off + bj * 128), x1 = *(const f32x4*)(xb + off + bj * 128 + 4);
                    *(f32x4*)(out + off + bj * 128) = acc[ai][bj][m][0] + x0; *(f32x4*)(out + off + bj * 128 + 4) = acc[ai][bj][m][1] + x1; } }
    }
};

__device__ __forceinline__ void norm_row_to_bf16(const float* src, const float* w, bf16_t* dst, int lane) {
    const f32x4* s = (const f32x4*)src + lane; const f32x4* wv = (const f32x4*)w + lane;
    f32x4 v[8]; float ss = 0.f;
#pragma unroll
    for (int j = 0; j < 8; ++j) { v[j] = s[64 * j]; ss += (v[j].x * v[j].x + v[j].y * v[j].y) + (v[j].z * v[j].z + v[j].w * v[j].w); }
    const float rstd = 1.0f / sqrtf(wave_sum(ss) * (1.0f / DM) + EPS);
    u32x2* o = (u32x2*)dst + lane;
#pragma unroll
    for (int j = 0; j < 8; ++j) { const f32x4 ww = wv[64 * j]; u32x2 r; r.x = pk2(v[j].x * rstd * ww.x, v[j].y * rstd * ww.y); r.y = pk2(v[j].z * rstd * ww.z, v[j].w * rstd * ww.w); o[64 * j] = r; }
}
__device__ __forceinline__ void transpose_item(const float* W, int ldw, int csrc, bf16_t* WT, int n0, int k0, LAS float* scr, int lane) {
#pragma unroll 8
    for (int i = 0; i < 32; ++i) { const int kk = 2 * i + (lane >> 5); scr[kk * 33 + (lane & 31)] = W[(size_t)(k0 + kk) * ldw + csrc + (lane & 31)]; }
    asm volatile("s_waitcnt lgkmcnt(0)" ::: "memory");
    const int c = lane & 7;
#pragma unroll
    for (int j = 0; j < 4; ++j) { const int n = (lane >> 3) + 8 * j; const LAS float* s = scr + (8 * c) * 33 + n;
        u32x4 o; o.x = pk2(s[0 * 33], s[1 * 33]); o.y = pk2(s[2 * 33], s[3 * 33]); o.z = pk2(s[4 * 33], s[5 * 33]); o.w = pk2(s[6 * 33], s[7 * 33]);
        *(u32x4*)(WT + (size_t)(n0 + n) * DM + k0 + 8 * c) = o; }
    asm volatile("s_waitcnt lgkmcnt(0)" ::: "memory");
}
__device__ __forceinline__ void phase_prep(const Params& p, LAS unsigned char* lds) {
    const int tid = threadIdx.x, lane = tid & 63, wave = tid >> 6;
    const int gw = blockIdx.x * 8 + wave, NGW = gridDim.x * 8;
    unsigned char* ws = p.ws;
    bf16_t* XB = (bf16_t*)(ws + WS_XB); bf16_t* MB = (bf16_t*)(ws + WS_MB);
    for (int r = gw; r < NTOK + NMR; r += NGW) {
        if (r < NP) norm_row_to_bf16(p.x_prompt + (size_t)r * DM, p.norm_w, XB + (size_t)r * DM, lane);
        else if (r < NTOK) norm_row_to_bf16(p.x_sample + (size_t)(r - NP) * DM, p.norm_w, XB + (size_t)r * DM, lane);
        else norm_row_to_bf16(p.mem + (size_t)(r - NTOK) * DM, p.mem_norm_w, MB + (size_t)(r - NTOK) * DM, lane);
    }
    LAS float* scr = (LAS float*)(lds + wave * 8704);
    constexpr int I_IN = 32 * (DINP / 32), I_M = 32 * (1024 / 32), I_O = 32 * (2048 / 32);
    bf16_t* WIN = (bf16_t*)(ws + WS_WIN); bf16_t* WM = (bf16_t*)(ws + WS_WM); bf16_t* WO = (bf16_t*)(ws + WS_WO); bf16_t* WR = (bf16_t*)(ws + WS_WR);
    for (int it = gw; it < I_IN + I_M + I_O; it += NGW) {
        int r = it;
        if (r < I_IN) { const int nb = r % (DINP / 32), kb = r / (DINP / 32), n0 = nb * 32; transpose_item(p.w_in, DIN, n0 + (n0 >= SRC_BR ? 16 : 0), WIN, n0, kb * 64, scr, lane); continue; }
        r -= I_IN;
        if (r < I_M) { const int nb = r % 32, kb = r / 32; transpose_item(p.w_mem, 1024, nb * 32, WM, nb * 32, kb * 64, scr, lane); continue; }
        r -= I_M;
        { const int nb = r % 64, kb = r / 64; transpose_item(p.w_out, 2048, nb * 32, WO, nb * 32, kb * 64, scr, lane); }
    }
    for (int i = blockIdx.x * NTHREADS + tid; i < 16 * DM; i += gridDim.x * NTHREADS) { const int r = i & 15, k = i >> 4; WR[r * DM + k] = (bf16_t)f2bf(p.w_in[(size_t)k * DIN + SRC_BR + r]); }
}

__device__ __forceinline__ void br_task(const bf16_t* XB, const bf16_t* WR, float* BR, int task, int wave, int lane) {
    const int fr = lane & 15, fq = lane >> 4, row0 = task * 128 + wave * 16;
    const bf16_t* ap = XB + (size_t)(row0 + fr) * DM + 8 * fq; const bf16_t* bp = WR + (size_t)fr * DM + 8 * fq;
    f32x4 acc = (f32x4){0.f, 0.f, 0.f, 0.f};
#pragma unroll 8
    for (int k0 = 0; k0 < DM; k0 += 32) { const bf16x8 a = *(const bf16x8*)(ap + k0), b = *(const bf16x8*)(bp + k0); acc = __builtin_amdgcn_mfma_f32_16x16x32_bf16(a, b, acc, 0, 0, 0); }
#pragma unroll
    for (int j = 0; j < 4; ++j) BR[(size_t)(row0 + 4 * fq + j) * 16 + fr] = acc[j];
}

__device__ __forceinline__ void mixA_task(const Params& p, LAS unsigned char* lds, int row0, int h, int L, bool write_cv) {
    const int tid = threadIdx.x, lane = tid & 63, wave = tid >> 6;
    const bf16_t* PROJ = (const bf16_t*)(p.ws + WS_PROJ); bf16_t* BRANCH = (bf16_t*)(p.ws + WS_BRANCH);
    LAS float* Wl = (LAS float*)lds;
    LAS bf16_t* vn = (LAS bf16_t*)(lds + 65536);
    LAS float* rs = (LAS float*)(lds + 65536 + 49152);
    __syncthreads();
    for (int t = wave * 16; t < wave * 16 + 16; ++t) {
        const u32x2* src = (const u32x2*)(PROJ + (size_t)(row0 + t) * DINP + C_AV) + lane; float ss = 0.f;
#pragma unroll
        for (int j = 0; j < 3; ++j) { const u32x2 w = src[64 * j]; const float a = bflo(w.x), b = bfhi(w.x), c = bflo(w.y), d = bfhi(w.y); ss += (a * a + b * b) + (c * c + d * d); }
        ss = wave_sum(ss);
        if (lane == 0) rs[t] = 1.0f / sqrtf(ss * (1.0f / 768.0f) + EPS);
    }
    for (int i = tid; i < 128 * 32; i += NTHREADS) ((LAS f32x4*)Wl)[i] = ((const f32x4*)(p.a_ws + (size_t)h * 16384))[i];
    __syncthreads();
    for (int i = tid; i < 128 * 192; i += NTHREADS) { const int t = i / 192, dd = i % 192;
        const float v = bf2f(PROJ[(size_t)(row0 + t) * DINP + C_AV + h * 192 + dd]) * rs[t] * p.a_vnorm_w[h * 192 + dd];
        vn[i] = (bf16_t)f2bf(v);
        if (write_cv) p.out[O_CV + (size_t)(row0 - NP + t) * 768 + h * 192 + dd] = v; }
    __syncthreads();
    if (tid < 384) {
        const int dd2 = tid % 96, ig = tid / 96;
        for (int k = 0; k < 32; ++k) {
            const int rl = ig + 4 * k, i = rl % L, cs = rl - i;
            float a0 = 0.f, a1 = 0.f;
            for (int j = 0; j <= i; ++j) { const float w = Wl[i * 128 + j]; const unsigned v = *(const LAS unsigned*)(vn + (cs + j) * 192 + 2 * dd2); a0 += w * bflo(v); a1 += w * bfhi(v); }
            const float bsv = p.a_bs[h * 128 + i]; a0 += bsv; a1 += bsv;
            const size_t rb = (size_t)(row0 + rl) * DINP + h * 192 + 2 * dd2;
            const unsigned uu = *(const unsigned*)(PROJ + rb + C_AU), gg = *(const unsigned*)(PROJ + rb + C_AG);
            const float o0 = bflo(uu) * a0 * silu(bflo(gg)), o1 = bfhi(uu) * a1 * silu(bfhi(gg));
            *(unsigned*)(BRANCH + (size_t)(row0 + rl) * DM + h * 192 + 2 * dd2) = pk2(o0, o1);
        }
    }
}

template <bool F32SRC>
__device__ __forceinline__ void mixX_task(const Params& p, LAS unsigned char* lds, const void* Ksrc, const void* Vsrc, int kvrow0, int h, int qrow0, int nq) {
    const int tid = threadIdx.x, lane = tid & 63, wave = tid >> 6;
    const bf16_t* PROJ = (const bf16_t*)(p.ws + WS_PROJ); bf16_t* BRANCH = (bf16_t*)(p.ws + WS_BRANCH);
    LAS unsigned char* Kl = lds;
    LAS unsigned char* Vl = lds + 69632;
    LAS float* qs = (LAS float*)(lds + 69632 + 65536) + wave * 128;
    LAS float* ps = (LAS float*)(lds + 69632 + 65536 + 4096) + wave * 256;
    __syncthreads();
    if (F32SRC) {
        const float* K = (const float*)Ksrc; const float* V = (const float*)Vsrc;
        for (int i = tid; i < 256 * 32; i += NTHREADS) { const int n = i >> 5, ch = i & 31; const size_t g = (size_t)(kvrow0 + n) * 512 + h * 128 + ch * 4;
            const f32x4 kv = *(const f32x4*)(K + g), vv = *(const f32x4*)(V + g);
            u32x2 a; a.x = pk2(kv.x, kv.y); a.y = pk2(kv.z, kv.w); *(LAS u32x2*)(Kl + n * 272 + ch * 8) = a;
            u32x2 b; b.x = pk2(vv.x, vv.y); b.y = pk2(vv.z, vv.w); *(LAS u32x2*)(Vl + n * 256 + ch * 8) = b; }
    } else {
        const bf16_t* K = (const bf16_t*)Ksrc; const bf16_t* V = (const bf16_t*)Vsrc;
        for (int i = tid; i < 256 * 16; i += NTHREADS) { const int n = i >> 4, ch = i & 15; const size_t g = (size_t)(kvrow0 + n) * 512 + h * 128 + ch * 8;
            *(LAS u32x4*)(Kl + n * 272 + ch * 16) = *(const u32x4*)(K + g); *(LAS u32x4*)(Vl + n * 256 + ch * 16) = *(const u32x4*)(V + g); }
    }
    __syncthreads();
    for (int qi = wave; qi < nq; qi += 8) {
        const int row = qrow0 + qi;
        { const unsigned w = *(const unsigned*)(PROJ + (size_t)row * DINP + C_XQ + h * 128 + 2 * lane); qs[2 * lane] = bflo(w) * 0.08838834764831845f; qs[2 * lane + 1] = bfhi(w) * 0.08838834764831845f; }
        asm volatile("s_waitcnt lgkmcnt(0)" ::: "memory");
        float s[4] = {0.f, 0.f, 0.f, 0.f};
        for (int c = 0; c < 16; ++c) {
            const f32x4 qa = *(const LAS f32x4*)(qs + 8 * c), qb = *(const LAS f32x4*)(qs + 8 * c + 4);
#pragma unroll
            for (int kk = 0; kk < 4; ++kk) { const u32x4 kv = *(const LAS u32x4*)(Kl + (lane + 64 * kk) * 272 + c * 16);
                s[kk] += (qa.x * bflo(kv.x) + qa.y * bfhi(kv.x)) + (qa.z * bflo(kv.y) + qa.w * bfhi(kv.y)) + (qb.x * bflo(kv.z) + qb.y * bfhi(kv.z)) + (qb.z * bflo(kv.w) + qb.w * bfhi(kv.w)); }
        }
        const float mx = wave_max(fmaxf(fmaxf(s[0], s[1]), fmaxf(s[2], s[3])));
        float e[4], sum = 0.f;
#pragma unroll
        for (int kk = 0; kk < 4; ++kk) { e[kk] = __expf(s[kk] - mx); sum += e[kk]; }
        const float inv = 1.0f / wave_sum(sum);
#pragma unroll
        for (int kk = 0; kk < 4; ++kk) ps[lane + 64 * kk] = e[kk] * inv;
        asm volatile("s_waitcnt lgkmcnt(0)" ::: "memory");
        float o0 = 0.f, o1 = 0.f;
        for (int n = 0; n < 256; n += 4) { const f32x4 pp = *(const LAS f32x4*)(ps + n);
#pragma unroll
            for (int j = 0; j < 4; ++j) { const unsigned v = *(const LAS unsigned*)(Vl + (n + j) * 256 + lane * 4); o0 += pp[j] * bflo(v); o1 += pp[j] * bfhi(v); } }
        const unsigned g = *(const unsigned*)(PROJ + (size_t)row * DINP + C_XG + h * 128 + 2 * lane);
        *(unsigned*)(BRANCH + (size_t)row * DM + 1536 + h * 128 + 2 * lane) = pk2(o0 * silu(bflo(g)), o1 * silu(bfhi(g)));
    }
}

__device__ __forceinline__ void mixB_task(const Params& p, LAS unsigned char* lds, int row0, int T, int h, const float* s0, float* sout) {
    const int tid = threadIdx.x, lane = tid & 63, wave = tid >> 6;
    const bf16_t* PROJ = (const bf16_t*)(p.ws + WS_PROJ); bf16_t* BRANCH = (bf16_t*)(p.ws + WS_BRANCH); const float* BR = (const float*)(p.ws + WS_BR);
    LAS float* qs = (LAS float*)lds;
    LAS float* ks = qs + 32 * 96;
    LAS float* al = ks + 32 * 96;
    LAS float* vs = al + 32 * 96;
    LAS float* po = vs + 32 * 192;
    const int e = tid % 192, hf = tid / 192, d0 = hf * 48;
    float S[48];
#pragma unroll
    for (int dd = 0; dd < 48; ++dd) S[dd] = (s0 && tid < 384) ? s0[(size_t)(d0 + dd) * 192 + e] : 0.f;
    const int TC = T < 32 ? T : 32;
    for (int t0 = 0; t0 < T; t0 += TC) {
        __syncthreads();
        for (int i = tid; i < TC * 96; i += NTHREADS) { const int t = i / 96, d = i % 96; const size_t row = (size_t)(row0 + t0 + t);
            float z = p.b_ba[h * 96 + d];
#pragma unroll
            for (int r = 0; r < 16; ++r) z += BR[row * 16 + r] * p.b_wa[r * 384 + h * 96 + d];
            const float la = (fminf(z, 0.f) - log1pf(__expf(-fabsf(z)))) * (1.0f / 16.0f);
            al[i] = __expf(la);
            qs[i] = bf2f(PROJ[row * DINP + C_BQ + h * 96 + d]) * 0.10206207261596577f;
            ks[i] = bf2f(PROJ[row * DINP + C_BK + h * 96 + d]); }
        for (int i = tid; i < TC * 192; i += NTHREADS) { const int t = i / 192, ee = i % 192; vs[i] = bf2f(PROJ[(size_t)(row0 + t0 + t) * DINP + C_BV + h * 192 + ee]); }
        __syncthreads();
        if (tid < 384) {
#pragma unroll 1
            for (int t = 0; t < TC; ++t) {
                const float v = vs[t * 192 + e]; float acc = 0.f;
#pragma unroll
                for (int d4 = 0; d4 < 12; ++d4) {
                    const f32x4 a4 = *(const LAS f32x4*)(al + t * 96 + d0 + 4 * d4), k4 = *(const LAS f32x4*)(ks + t * 96 + d0 + 4 * d4), q4 = *(const LAS f32x4*)(qs + t * 96 + d0 + 4 * d4);
#pragma unroll
                    for (int j = 0; j < 4; ++j) { S[4 * d4 + j] = a4[j] * S[4 * d4 + j] + k4[j] * v; acc += q4[j] * S[4 * d4 + j]; }
                    if ((d4 % 3) == 2) asm volatile("" ::: "memory");
                }
                po[(hf * 32 + t) * 192 + e] = acc;
            }
        }
        __syncthreads();
        for (int t = wave; t < TC; t += 8) {
            const size_t row = (size_t)(row0 + t0 + t);
            float o[3], ss = 0.f;
#pragma unroll
            for (int j = 0; j < 3; ++j) { o[j] = po[t * 192 + lane + 64 * j] + po[(32 + t) * 192 + lane + 64 * j]; ss += o[j] * o[j]; }
            const float rstd = 1.0f / sqrtf(wave_sum(ss) * (1.0f / 192.0f) + EPS);
#pragma unroll
            for (int j = 0; j < 3; ++j) { const int ee = lane + 64 * j; const float g = bf2f(PROJ[row * DINP + C_BG + h * 192 + ee]);
                BRANCH[row * DM + 768 + h * 192 + ee] = (bf16_t)f2bf(o[j] * rstd * p.b_onorm_w[ee] * silu(g)); }
        }
    }
    if (tid < 384) {
#pragma unroll
        for (int dd = 0; dd < 48; ++dd) sout[(size_t)(d0 + dd) * 192 + e] = S[dd];
    }
}

__device__ __forceinline__ void phase_mix(const Params& p, LAS unsigned char* lds) {
    const int G = gridDim.x, c = blockIdx.x;
    const int NBP = 16, NBS = 512, NA = 256 + 32, NXP = 256, NXS = 512, NTASK = NBP + NBS + NA + NXP + NXS;
    for (int t = c; t < NTASK; t += G) {
        int r = t;
        if (r < NBP + NBS) {
            int row0, T, h; const float* s0; float* so;
            if (r < NBP) { const int b = r >> 2; h = r & 3; row0 = b * SEQ; T = SEQ; s0 = nullptr; so = p.out + O_SP + (size_t)(b * 4 + h) * 96 * 192; }
            else { const int q = r - NBP, b = q >> 2; h = q & 3; row0 = NP + b * 8; T = 8; s0 = p.state + (size_t)(b * 4 + h) * 96 * 192; so = p.out + O_SS + (size_t)(b * 4 + h) * 96 * 192; }
            mixB_task(p, lds, row0, T, h, s0, so); continue; }
        r -= NBP + NBS;
        if (r < NA) { const int h = r & 3, blk = r >> 2; const bool smp = r >= 256; mixA_task(p, lds, smp ? NP + (blk - 64) * 128 : blk * 128, h, smp ? 8 : 128, smp); continue; }
        r -= NA;
        if (r < NXP) { const int qt = r & 15, h = (r >> 4) & 3, b = r >> 6; mixX_task<false>(p, lds, p.ws + WS_MKB, p.ws + WS_MVB, b * 256, h, b * SEQ + qt * 128, 128); continue; }
        r -= NXP;
        { const int h = r & 3, b = r >> 2; mixX_task<true>(p, lds, p.cache_k, p.cache_v, b * 256, h, NP + b * 8, 8); }
    }
}

__device__ __forceinline__ void phase_final(const Params& p) {
    const int lane = threadIdx.x & 63, wave = threadIdx.x >> 6;
    const int gw = blockIdx.x * 8 + wave, NGW = gridDim.x * 8;
    for (int r = gw; r < NTOK; r += NGW) {
        f32x4* s = (f32x4*)(p.out + (size_t)r * DM) + lane; const f32x4* wv = (const f32x4*)p.final_w + lane;
        f32x4 v[8]; float ss = 0.f;
#pragma unroll
        for (int j = 0; j < 8; ++j) { v[j] = s[64 * j]; ss += (v[j].x * v[j].x + v[j].y * v[j].y) + (v[j].z * v[j].z + v[j].w * v[j].w); }
        const float rstd = 1.0f / sqrtf(wave_sum(ss) * (1.0f / DM) + EPS);
#pragma unroll
        for (int j = 0; j < 8; ++j) { const f32x4 ww = wv[64 * j]; s[64 * j] = v[j] * rstd * ww; }
    }
}


#define XB_TMO      128
#define XB_XCNT(j)  (256  + 64 * (j))
#define XB_XSUB(j)  (1280 + 64 * (j))
#define XB_XGEN(j)  (2304 + 64 * (j))
#define XB_TOP      3328
#define XB_TOPGEN   3392
#define XCD_BAR_WORDS 3456
#define XB_SPIN_CAP (1u << 18)
__device__ __forceinline__ unsigned xb_ld(unsigned* p)              { return __hip_atomic_load(p, __ATOMIC_RELAXED, __HIP_MEMORY_SCOPE_AGENT); }
__device__ __forceinline__ unsigned xb_add(unsigned* p, unsigned v) { return __hip_atomic_fetch_add(p, v, __ATOMIC_RELAXED, __HIP_MEMORY_SCOPE_AGENT); }
__device__ __forceinline__ unsigned xb_xcc_id() { return (unsigned)__builtin_amdgcn_s_getreg((3 << 11) | 20) & 0xFu; }
#define XB_SPIN(cond, bar) do { unsigned _sp = 0; while (cond) { __builtin_amdgcn_s_sleep(1); \
    if ((++_sp & 255u) == 0u) { if (xb_ld(&(bar)[XB_TMO])) break; if (_sp > XB_SPIN_CAP) { atomicAdd(&(bar)[XB_TMO], 1u); break; } } } } while (0)
struct XcdBarrier { unsigned* bar; unsigned x; volatile LAS unsigned* st; };
__device__ __forceinline__ XcdBarrier xcd_barrier_post(unsigned* bar, volatile LAS unsigned* st) {
    XcdBarrier b; b.bar = bar; b.x = xb_xcc_id(); b.st = st;
    if (threadIdx.x == 0) (void)xb_add(&bar[XB_XCNT(b.x)], 1u);
    return b;
}
__device__ __forceinline__ void xcd_barrier_complete(unsigned* bar, unsigned x, unsigned& nloc, unsigned& nx) {
    const unsigned G = gridDim.x * gridDim.y * gridDim.z;
    unsigned sum, cnt, mine, sp = 0u;
    for (;;) {
        sum = 0u; cnt = 0u; mine = 0u;
#pragma unroll
        for (unsigned j = 0; j < 16; ++j) { const unsigned c = xb_ld(&bar[XB_XCNT(j)]); sum += c; cnt += (c > 0u) ? 1u : 0u; mine = (j == x) ? c : mine; }
        if (sum == G) break;
        __builtin_amdgcn_s_sleep(1);
        if ((++sp & 255u) == 0u) { if (xb_ld(&bar[XB_TMO])) break; if (sp > XB_SPIN_CAP) { atomicAdd(&bar[XB_TMO], 1u); break; } }
    }
    nloc = mine > 0u ? mine : 1u; nx = cnt > 0u ? cnt : 1u;
}
__device__ __forceinline__ void xcd_barrier(const XcdBarrier& b) {
    asm volatile("s_waitcnt vmcnt(0)" ::: "memory");
    __syncthreads();
    if (threadIdx.x == 0) {
        unsigned* bar = b.bar;
        __builtin_amdgcn_s_waitcnt(0);
        unsigned nloc = b.st[0], nx = b.st[1];
        if (nloc == 0u) { xcd_barrier_complete(bar, b.x, nloc, nx); b.st[0] = nloc; b.st[1] = nx; }
        const unsigned old = xb_add(&bar[XB_XSUB(b.x)], 1u);
        const unsigned gen = old / nloc;
        if (old + 1u == (gen + 1u) * nloc) {
            __builtin_amdgcn_fence(__ATOMIC_RELEASE, "agent");
            asm volatile("s_waitcnt vmcnt(0)" ::: "memory");
            const unsigned og = xb_add(&bar[XB_TOP], 1u);
            const unsigned tg = og / nx;
            if (og + 1u == (tg + 1u) * nx) xb_add(&bar[XB_TOPGEN], 1u);
            else XB_SPIN(xb_ld(&bar[XB_TOPGEN]) == tg, bar);
            __builtin_amdgcn_fence(__ATOMIC_ACQUIRE, "agent");
            xb_add(&bar[XB_XGEN(b.x)], 1u);
            asm volatile("s_waitcnt vmcnt(0)" ::: "memory");
        } else {
            XB_SPIN(xb_ld(&bar[XB_XGEN(b.x)]) == gen, bar);
            __builtin_amdgcn_fence(__ATOMIC_ACQUIRE, "agent");
            asm volatile("s_waitcnt vmcnt(0)" ::: "memory");
        }
    }
    __syncthreads();
}

__global__ void __launch_bounds__(NTHREADS, 2) fwd(Params p) {
    extern __shared__ __attribute__((aligned(16))) unsigned char lds_raw[];
    LAS unsigned char* lds = (LAS unsigned char*)lds_raw;
    const int lo = p.ph_lo, hi = p.ph_hi;
    volatile LAS unsigned* MISC = (volatile LAS unsigned*)(lds + LDS_MISC);
    if (threadIdx.x < 64) MISC[threadIdx.x] = 0u;
    __syncthreads();
    XcdBarrier bar; bar.bar = (unsigned*)(p.ws + WS_CTL) + 4096; bar.x = 0; bar.st = nullptr;
    if (hi - lo > 1) bar = xcd_barrier_post((unsigned*)(p.ws + WS_CTL) + 4096, MISC + 8);
#define BOTH(k) (IN(k) && IN((k) + 1))
#ifndef PH_MASK
#define PH_MASK 31
#endif
#define IN(k) (((PH_MASK >> (k)) & 1) && lo <= (k) && (k) < hi)
    if (IN(0)) { phase_prep(p, lds); if (BOTH(0)) xcd_barrier(bar); }
    if (IN(1)) {
        Prog1 P; P.XB = (const char*)(p.ws + WS_XB); P.WIN = (const char*)(p.ws + WS_WIN); P.MB = (const char*)(p.ws + WS_MB); P.WM = (const char*)(p.ws + WS_WM);
        P.PROJ = (bf16_t*)(p.ws + WS_PROJ); P.out = p.out; P.MKB = (bf16_t*)(p.ws + WS_MKB); P.MVB = (bf16_t*)(p.ws + WS_MVB); P.G = gridDim.x; P.c = blockIdx.x;
        pg8::gemm_phase(lds, P);
        const int wave = threadIdx.x >> 6, lane = threadIdx.x & 63;
        for (int t = (blockIdx.x + gridDim.x - 40) % gridDim.x; t < 72; t += gridDim.x) br_task((const bf16_t*)(p.ws + WS_XB), (const bf16_t*)(p.ws + WS_WR), (float*)(p.ws + WS_BR), t, wave, lane);
        if (BOTH(1)) xcd_barrier(bar);
    }
    if (IN(2)) { phase_mix(p, lds); if (BOTH(2)) xcd_barrier(bar); }
    if (IN(3)) {
        Prog3 P; P.BRANCH = (const char*)(p.ws + WS_BRANCH); P.WO = (const char*)(p.ws + WS_WO); P.xp = p.x_prompt; P.xs = p.x_sample; P.out = p.out; P.G = gridDim.x; P.c = blockIdx.x;
        pg8::gemm_phase(lds, P);
        if (BOTH(3)) xcd_barrier(bar);
    }
    if (IN(4)) phase_final(p);
#undef IN
#undef BOTH
}

extern "C" void kernel_launch(void* const* d_in, const int* in_sizes, int n_in, void* d_out, int out_size, void* d_ws, size_t ws_size, hipStream_t stream) {
    static int grid = 0;
    if (grid == 0) {
        if (n_in != 18 || ws_size < WS_END) { fprintf(stderr, "kernel_launch: unexpected n_in %d or ws_size %zu\n", n_in, ws_size); grid = -1; return; }
        int dev = 0, cus = 0;
        if (hipGetDevice(&dev) != hipSuccess || hipDeviceGetAttribute(&cus, hipDeviceAttributeMultiprocessorCount, dev) != hipSuccess) { grid = -1; return; }
        if (hipFuncSetAttribute((const void*)fwd, hipFuncAttributeMaxDynamicSharedMemorySize, LDS_BYTES) != hipSuccess) { fprintf(stderr, "kernel_launch: hipFuncSetAttribute failed\n"); grid = -1; return; }
        grid = cus > 0 ? cus : 256;
    }
    if (grid < 0) return;
    Params p{};
    const float** pp = (const float**)&p;
    for (int i = 0; i < 18; ++i) pp[i] = (const float*)d_in[i];
    p.out = (float*)d_out; p.ws = (unsigned char*)d_ws;
    (void)hipMemsetAsync((char*)d_ws + WS_CTL, 0, 65536, stream);
#if N_LAUNCH_MODE == 1
    p.ph_lo = 0; p.ph_hi = 5; hipLaunchKernelGGL(fwd, dim3(grid), dim3(NTHREADS), LDS_BYTES, stream, p);
#else
    for (int ph = 0; ph < 5; ++ph) { p.ph_lo = ph; p.ph_hi = ph + 1; hipLaunchKernelGGL(fwd, dim3(grid), dim3(NTHREADS), LDS_BYTES, stream, p); }
#endif
}
```

```cpp
#include <hip/hip_runtime.h>
#include <cstdio>
#include <cstdint>

#define LAS __attribute__((address_space(3)))
typedef unsigned short bf16_t;
typedef short bf16x8 __attribute__((ext_vector_type(8)));
typedef float f32x4 __attribute__((ext_vector_type(4)));
typedef float f32x2 __attribute__((ext_vector_type(2)));
typedef unsigned u32x4 __attribute__((ext_vector_type(4)));
typedef unsigned u32x2 __attribute__((ext_vector_type(2)));

#ifndef N_LAUNCH_MODE
#define N_LAUNCH_MODE 1
#endif

constexpr int DM = 2048;
constexpr int NP = 8192, NS = 1024, NTOK = NP + NS, NMR = 1024;
constexpr int SEQ = 2048, DSEQ = 8, NB = 4, DB = 128, NMEM = 256;
constexpr int DIN = 5648, DINP = 5632;
constexpr int C_AU = 0, C_AV = 768, C_AG = 1536, C_BQ = 2304, C_BK = 2688, C_BV = 3072, C_BG = 3840, C_XQ = 4608, C_XG = 5120;
constexpr int SRC_BR = 3840;
constexpr float EPS = 1e-6f;
constexpr size_t O_Y = 0, O_MK = 18874368, O_MV = 19398656, O_SP = 19922944, O_SS = 20217856, O_CV = 29655040;
constexpr size_t MiB = 1u << 20;
constexpr size_t WS_CTL = 0, CTL_BYTES = 1 * MiB;
constexpr size_t WS_XB = 2 * MiB, WS_MB = 38 * MiB, WS_WIN = 42 * MiB, WS_WM = 64 * MiB, WS_WO = 68 * MiB, WS_WR = 76 * MiB, WS_BR = 77 * MiB,
                 WS_MKB = 78 * MiB, WS_MVB = 79 * MiB, WS_PROJ = 80 * MiB, WS_BRANCH = 180 * MiB, WS_END = 216 * MiB;
constexpr int LDS_MISC = 147456;
constexpr int LDS_BYTES = 148480;
constexpr int NTHREADS = 512;

struct Params {
    const float *x_prompt, *x_sample, *mem, *state, *cache_k, *cache_v, *norm_w, *w_in, *a_vnorm_w, *a_ws, *a_bs, *b_wa, *b_ba, *b_onorm_w,
                *mem_norm_w, *w_mem, *w_out, *final_w;
    float* out; unsigned char* ws;
    int ph_lo, ph_hi;
};

__device__ __forceinline__ unsigned f2bf(float f) { unsigned u = __builtin_bit_cast(unsigned, f); return (u + 0x7fffu + ((u >> 16) & 1u)) >> 16; }
__device__ __forceinline__ unsigned pk2(float lo, float hi) { return f2bf(lo) | (f2bf(hi) << 16); }
__device__ __forceinline__ float bflo(unsigned w) { return __builtin_bit_cast(float, w << 16); }
__device__ __forceinline__ float bfhi(unsigned w) { return __builtin_bit_cast(float, w & 0xffff0000u); }
__device__ __forceinline__ float bf2f(bf16_t b) { return __builtin_bit_cast(float, ((unsigned)b) << 16); }
__device__ __forceinline__ unsigned cvt_pk_bf16(float lo, float hi) { unsigned r; asm volatile("v_cvt_pk_bf16_f32 %0, %1, %2" : "=v"(r) : "v"(lo), "v"(hi)); return r; }
__device__ __forceinline__ float wave_sum(float v) {
#pragma unroll
    for (int o = 1; o < 64; o <<= 1) v += __shfl_xor(v, o);
    return v;
}
__device__ __forceinline__ float wave_max(float v) {
#pragma unroll
    for (int o = 1; o < 64; o <<= 1) v = fmaxf(v, __shfl_xor(v, o));
    return v;
}
__device__ __forceinline__ float silu(float x) { return x / (1.0f + __expf(-x)); }

namespace pg8 {
constexpr int BM = 256, BK = 64, HALF = 128, HTB = HALF * BK * 2, STAGE_BYTES = 8 * HTB, NXCD = 8, WGM = 8;
constexpr int K = DM, NT = K / BK;
constexpr size_t TSTEP = (size_t)BM * K * 2;
__device__ __forceinline__ int lds_byte(int r, int c) { const int st = (r >> 4) * 2 + (c >> 5), rr = r & 15, cc = c & 31, ob = rr * 64 + cc * 2; return st * 1024 + (ob ^ (((ob >> 9) & 1) << 5)); }
__device__ __forceinline__ void stage_rc(int b, int& R, int& C) { const int st = b / 1024, sb = b % 1024, swz = sb ^ (((sb >> 9) & 1) << 5); R = (st >> 1) * 16 + swz / 64; C = (st & 1) * 32 + (swz % 64) / 2; }
__device__ __forceinline__ int perm32(int rho) { const int n = rho >> 4, i = rho & 15; return 8 * (i >> 2) + 4 * n + (i & 3); }
struct Unit { int pm, pn, kind; };
__device__ __forceinline__ void static_tile(int L, int nM, int nN, int& pm, int& pn) {
    const int nwg = nM * nN; int wgid = L; { const int q = nwg / NXCD, r = nwg % NXCD, xcd = wgid % NXCD, off = wgid / NXCD; wgid = (xcd < r ? xcd * (q + 1) : r * (q + 1) + (xcd - r) * q) + off; }
    const int nig = WGM * nN, gid = wgid / nig, fm = gid * WGM, gsz = (nM - fm) < WGM ? (nM - fm) : WGM;
    pm = fm + ((wgid % nig) % gsz); pn = (wgid % nig) / gsz;
}
typedef f32x4 Acc[2][2][4][2];

template <class Prog>
__device__ __forceinline__ void gemm_phase(LAS unsigned char* lds, const Prog& P) {
    const int tid = threadIdx.x, wid = __builtin_amdgcn_readfirstlane(tid >> 6), lane = tid & 63, wr = wid >> 2, wc = wid & 3, fr = lane & 15, fq = lane >> 4;
    unsigned voffA[2], voffB[2];
#pragma unroll
    for (int i = 0; i < 2; ++i) { int R, C; stage_rc(tid * 16 + i * 8192, R, C); const int Rb = (R & ~31) + perm32(R & 31);
        voffA[i] = (unsigned)(R * K + C) * 2u; voffB[i] = (unsigned)(Rb * K + C) * 2u; }
    const size_t kstep = (size_t)(BK * 2);
    const size_t hstep = (size_t)HALF * K * 2;
    const unsigned ldsw = (unsigned)wid * 1024u;
    const int aoff = lds_byte(wr * 64 + fr, fq * 8), boff = lds_byte(wc * 32 + fr, fq * 8);
#define PG8_SA(b, h) (((b) * 2 + (h)) * HTB)
#define PG8_SB(b, h) ((4 + (b) * 2 + (h)) * HTB)
#define PG8_STAGE(bufoff, gbase, voff) do { _Pragma("unroll") for (int _i = 0; _i < 2; ++_i) \
        __builtin_amdgcn_global_load_lds((const unsigned*)((const char*)(gbase) + (voff)[_i]), (LAS unsigned*)(lds + (bufoff) + ldsw + _i * 8192), 16, 0, 0); } while (0)
#define PG8_LDA(dst, b, h) do { _Pragma("unroll") for (int m = 0; m < 4; ++m) _Pragma("unroll") for (int k = 0; k < 2; ++k) dst[m][k] = *(const LAS bf16x8*)(lds + PG8_SA(b, h) + aoff + m * 2048 + k * 1024); } while (0)
#define PG8_LDB(dst, b, h) do { _Pragma("unroll") for (int n = 0; n < 2; ++n) _Pragma("unroll") for (int k = 0; k < 2; ++k) dst[n][k] = *(const LAS bf16x8*)(lds + PG8_SB(b, h) + boff + n * 2048 + k * 1024); } while (0)
#define PG8_MMA(ai, bj, At, Bt) do { __builtin_amdgcn_s_setprio(1); _Pragma("unroll") for (int m = 0; m < 4; ++m) _Pragma("unroll") for (int n = 0; n < 2; ++n) _Pragma("unroll") for (int k = 0; k < 2; ++k) \
        acc[ai][bj][m][n] = __builtin_amdgcn_mfma_f32_16x16x32_bf16(Bt[n][k], At[m][k], acc[ai][bj][m][n], 0, 0, 0); __builtin_amdgcn_s_setprio(0); } while (0)
#define PG8_WAIT_V(n) asm volatile("s_waitcnt vmcnt(" #n ")" ::: "memory")
#define PG8_WAIT_L(n) asm volatile("s_waitcnt lgkmcnt(" #n ")" ::: "memory")
#define PG8_BAR __builtin_amdgcn_s_barrier()
#define PG8_SCHED __builtin_amdgcn_sched_barrier(0)
    Unit cur, nxt; int ui = 0;
    if (!P.next(0, cur)) return;
    Acc acc;
#pragma unroll
    for (int a = 0; a < 2; ++a)
#pragma unroll
        for (int b = 0; b < 2; ++b)
#pragma unroll
            for (int m = 0; m < 4; ++m)
#pragma unroll
                for (int n = 0; n < 2; ++n) acc[a][b][m][n] = (f32x4){0.f, 0.f, 0.f, 0.f};
    bf16x8 At[4][2], B0[2][2], B1[2][2];
    const char* cA = P.a_ptr(cur); const char* cB = P.b_ptr(cur);
    PG8_STAGE(PG8_SB(0, 0), cB, voffB); PG8_STAGE(PG8_SA(0, 0), cA, voffA); PG8_STAGE(PG8_SB(0, 1), cB + hstep, voffB); PG8_STAGE(PG8_SA(0, 1), cA + hstep, voffA);
    if (wr == 1) PG8_BAR;
    PG8_WAIT_V(4); PG8_BAR;
    PG8_STAGE(PG8_SB(1, 0), cB + kstep, voffB); PG8_STAGE(PG8_SA(1, 0), cA + kstep, voffA); PG8_STAGE(PG8_SB(1, 1), cB + hstep + kstep, voffB);
    PG8_WAIT_V(6); PG8_BAR;
    for (;;) {
        const bool has_next = P.next(ui + 1, nxt);
        const char* nA = has_next ? P.a_ptr(nxt) : cA; const char* nB = has_next ? P.b_ptr(nxt) : cB;
        for (int t = 0; t < NT; t += 2) {
            const bool last = (t == NT - 2);
            const char* a1 = cA + (size_t)(t + 1) * kstep;
            const char* a2 = last ? nA : cA + (size_t)(t + 2) * kstep; const char* b2 = last ? nB : cB + (size_t)(t + 2) * kstep;
            const char* a3 = a2 + kstep; const char* b3 = b2 + kstep;
            PG8_LDB(B0, 0, 0); PG8_SCHED; PG8_LDA(At, 0, 0); PG8_STAGE(PG8_SA(1, 1), a1 + hstep, voffA);
            PG8_WAIT_L(8); PG8_BAR; PG8_WAIT_L(0); PG8_MMA(0, 0, At, B0); PG8_BAR; PG8_SCHED;
            PG8_LDB(B1, 0, 1); PG8_STAGE(PG8_SB(0, 0), b2, voffB);
            PG8_BAR; PG8_WAIT_L(0); PG8_MMA(0, 1, At, B1); PG8_BAR;
            PG8_LDA(At, 0, 1); PG8_STAGE(PG8_SA(0, 0), a2, voffA);
            PG8_BAR; PG8_WAIT_L(0); PG8_MMA(1, 0, At, B0); PG8_BAR; PG8_SCHED;
            PG8_STAGE(PG8_SB(0, 1), b2 + hstep, voffB);
            PG8_WAIT_V(6); PG8_BAR; PG8_MMA(1, 1, At, B1); PG8_BAR;
            PG8_LDB(B0, 1, 0); PG8_SCHED; PG8_LDA(At, 1, 0); PG8_STAGE(PG8_SA(0, 1), a2 + hstep, voffA);
            PG8_WAIT_L(8); PG8_BAR; PG8_WAIT_L(0); PG8_MMA(0, 0, At, B0); PG8_BAR; PG8_SCHED;
            PG8_LDB(B1, 1, 1); PG8_STAGE(PG8_SB(1, 0), b3, voffB);
            PG8_BAR; PG8_WAIT_L(0); PG8_MMA(0, 1, At, B1); PG8_BAR;
            PG8_LDA(At, 1, 1); PG8_STAGE(PG8_SA(1, 0), a3, voffA);
            PG8_BAR; PG8_WAIT_L(0); PG8_MMA(1, 0, At, B0); PG8_BAR; PG8_SCHED;
            PG8_STAGE(PG8_SB(1, 1), b3 + hstep, voffB);
            PG8_WAIT_V(6); PG8_BAR; PG8_MMA(1, 1, At, B1); PG8_BAR;
        }
        P.epi(acc, cur, wr, wc, fr, fq);
        if (!has_next) break;
#pragma unroll
        for (int a = 0; a < 2; ++a)
#pragma unroll
            for (int b = 0; b < 2; ++b)
#pragma unroll
                for (int m = 0; m < 4; ++m)
#pragma unroll
                    for (int n = 0; n < 2; ++n) acc[a][b][m][n] = (f32x4){0.f, 0.f, 0.f, 0.f};
        cur = nxt; cA = nA; cB = nB; ++ui;
    }
    PG8_WAIT_V(0);
    if (wr == 0) PG8_BAR;
    PG8_BAR;
#undef PG8_SA
#undef PG8_SB
#undef PG8_STAGE
#undef PG8_LDA
#undef PG8_LDB
#undef PG8_MMA
#undef PG8_WAIT_V
#undef PG8_WAIT_L
#undef PG8_BAR
#undef PG8_SCHED
}
}

struct Prog1 {
    const char *XB, *WIN, *MB, *WM; bf16_t* PROJ; float* out; bf16_t *MKB, *MVB; int G, c;
    __device__ __forceinline__ bool next(int i, pg8::Unit& u) const {
        const int L = i * G + c; if (L >= 808) return false;
        if (L < 792) { pg8::static_tile(L, 36, 22, u.pm, u.pn); u.kind = 0; } else { const int r = L - 792; u.pm = r >> 2; u.pn = r & 3; u.kind = 1; }
        return true;
    }
    __device__ __forceinline__ const char* a_ptr(const pg8::Unit& u) const { return (u.kind == 0 ? XB : MB) + (size_t)u.pm * pg8::TSTEP; }
    __device__ __forceinline__ const char* b_ptr(const pg8::Unit& u) const { return (u.kind == 0 ? WIN : WM) + (size_t)u.pn * pg8::TSTEP; }
    __device__ __forceinline__ void epi(const pg8::Acc& acc, const pg8::Unit& u, int wr, int wc, int fr, int fq) const {
        const int row0 = u.pm * 256 + wr * 64 + fr;
        if (u.kind == 0) {
            const int col0 = u.pn * 256 + wc * 32 + 8 * fq;
#pragma unroll
            for (int ai = 0; ai < 2; ++ai)
#pragma unroll
                for (int m = 0; m < 4; ++m) { bf16_t* rowp = PROJ + (size_t)(row0 + ai * 128 + m * 16) * DINP + col0;
#pragma unroll
                    for (int bj = 0; bj < 2; ++bj) { const f32x4 v0 = acc[ai][bj][m][0], v1 = acc[ai][bj][m][1];
                        u32x4 w; w.x = cvt_pk_bf16(v0[0], v0[1]); w.y = cvt_pk_bf16(v0[2], v0[3]); w.z = cvt_pk_bf16(v1[0], v1[1]); w.w = cvt_pk_bf16(v1[2], v1[3]);
                        *(u32x4*)(rowp + bj * 128) = w; } }
        } else {
            const int col0 = (u.pn & 1) * 256 + wc * 32 + 8 * fq;
            float* dst = out + (u.pn < 2 ? O_MK : O_MV); bf16_t* dstb = (u.pn < 2 ? MKB : MVB);
#pragma unroll
            for (int ai = 0; ai < 2; ++ai)
#pragma unroll
                for (int m = 0; m < 4; ++m) { const size_t off = (size_t)(row0 + ai * 128 + m * 16) * 512 + col0;
#pragma unroll
                    for (int bj = 0; bj < 2; ++bj) { const f32x4 v0 = acc[ai][bj][m][0], v1 = acc[ai][bj][m][1];
                        *(f32x4*)(dst + off + bj * 128) = v0; *(f32x4*)(dst + off + bj * 128 + 4) = v1;
                        u32x4 w; w.x = cvt_pk_bf16(v0[0], v0[1]); w.y = cvt_pk_bf16(v0[2], v0[3]); w.z = cvt_pk_bf16(v1[0], v1[1]); w.w = cvt_pk_bf16(v1[2], v1[3]);
                        *(u32x4*)(dstb + off + bj * 128) = w; } }
        }
    }
};
struct Prog3 {
    const char *BRANCH, *WO; const float *xp, *xs; float* out; int G, c;
    __device__ __forceinline__ bool next(int i, pg8::Unit& u) const {
        const int L = i * G + c; if (L >= 288) return false;
        pg8::static_tile(L, 36, 8, u.pm, u.pn); u.kind = 2; return true;
    }
    __device__ __forceinline__ const char* a_ptr(const pg8::Unit& u) const { return BRANCH + (size_t)u.pm * pg8::TSTEP; }
    __device__ __forceinline__ const char* b_ptr(const pg8::Unit& u) const { return WO + (size_t)u.pn * pg8::TSTEP; }
    __device__ __forceinline__ void epi(const pg8::Acc& acc, const pg8::Unit& u, int wr, int wc, int fr, int fq) const {
        const int row0 = u.pm * 256 + wr * 64 + fr; const int col0 = u.pn * 256 + wc * 32 + 8 * fq;
        const float* xb = (u.pm < 32) ? xp : (xs - (size_t)NP * DM);
#pragma unroll
        for (int ai = 0; ai < 2; ++ai)
#pragma unroll
            for (int m = 0; m < 4; ++m) { const size_t off = (size_t)(row0 + ai * 128 + m * 16) * DM + col0;
#pragma unroll
                for (int bj = 0; bj < 2; ++bj) { const f32x4 x0 = *(const f32x4*)(xb + off + bj * 128), x1 = *(const f32x4*)(xb + off + bj * 128 + 4);
                    *(f32x4*)(out + off + bj * 128) = acc[ai][bj][m][0] + x0; *(f32x4*)(out + off + bj * 128 + 4) = acc[ai][bj][m][1] + x1; } }
    }
};

__device__ __forceinline__ void norm_row_to_bf16(const float* src, const float* w, bf16_t* dst, int lane) {
    const f32x4* s = (const f32x4*)src + lane; const f32x4* wv = (const f32x4*)w + lane;
    f32x4 v[8]; float ss = 0.f;
#pragma unroll
    for (int j = 0; j < 8; ++j) { v[j] = s[64 * j]; ss += (v[j].x * v[j].x + v[j].y * v[j].y) + (v[j].z * v[j].z + v[j].w * v[j].w); }
    const float rstd = 1.0f / sqrtf(wave_sum(ss) * (1.0f / DM) + EPS);
    u32x2* o = (u32x2*)dst + lane;
#pragma unroll
    for (int j = 0; j < 8; ++j) { const f32x4 ww = wv[64 * j]; u32x2 r; r.x = pk2(v[j].x * rstd * ww.x, v[j].y * rstd * ww.y); r.y = pk2(v[j].z * rstd * ww.z, v[j].w * rstd * ww.w); o[64 * j] = r; }
}
__device__ __forceinline__ void transpose_item(const float* W, int ldw, int csrc, bf16_t* WT, int n0, int k0, LAS float* scr, int lane) {
#pragma unroll 8
    for (int i = 0; i < 32; ++i) { const int kk = 2 * i + (lane >> 5); scr[kk * 33 + (lane & 31)] = W[(size_t)(k0 + kk) * ldw + csrc + (lane & 31)]; }
    asm volatile("s_waitcnt lgkmcnt(0)" ::: "memory");
    const int c = lane & 7;
#pragma unroll
    for (int j = 0; j < 4; ++j) { const int n = (lane >> 3) + 8 * j; const LAS float* s = scr + (8 * c) * 33 + n;
        u32x4 o; o.x = pk2(s[0 * 33], s[1 * 33]); o.y = pk2(s[2 * 33], s[3 * 33]); o.z = pk2(s[4 * 33], s[5 * 33]); o.w = pk2(s[6 * 33], s[7 * 33]);
        *(u32x4*)(WT + (size_t)(n0 + n) * DM + k0 + 8 * c) = o; }
    asm volatile("s_waitcnt lgkmcnt(0)" ::: "memory");
}
__device__ __forceinline__ void phase_prep(const Params& p, LAS unsigned char* lds) {
    const int tid = threadIdx.x, lane = tid & 63, wave = tid >> 6;
    const int gw = blockIdx.x * 8 + wave, NGW = gridDim.x * 8;
    unsigned char* ws = p.ws;
    bf16_t* XB = (bf16_t*)(ws + WS_XB); bf16_t* MB = (bf16_t*)(ws + WS_MB);
    for (int r = gw; r < NTOK + NMR; r += NGW) {
        if (r < NP) norm_row_to_bf16(p.x_prompt + (size_t)r * DM, p.norm_w, XB + (size_t)r * DM, lane);
        else if (r < NTOK) norm_row_to_bf16(p.x_sample + (size_t)(r - NP) * DM, p.norm_w, XB + (size_t)r * DM, lane);
        else norm_row_to_bf16(p.mem + (size_t)(r - NTOK) * DM, p.mem_norm_w, MB + (size_t)(r - NTOK) * DM, lane);
    }
    LAS float* scr = (LAS float*)(lds + wave * 8704);
    constexpr int I_IN = 32 * (DINP / 32), I_M = 32 * (1024 / 32), I_O = 32 * (2048 / 32);
    bf16_t* WIN = (bf16_t*)(ws + WS_WIN); bf16_t* WM = (bf16_t*)(ws + WS_WM); bf16_t* WO = (bf16_t*)(ws + WS_WO); bf16_t* WR = (bf16_t*)(ws + WS_WR);
    for (int it = gw; it < I_IN + I_M + I_O; it += NGW) {
        int r = it;
        if (r < I_IN) { const int nb = r % (DINP / 32), kb = r / (DINP / 32), n0 = nb * 32; transpose_item(p.w_in, DIN, n0 + (n0 >= SRC_BR ? 16 : 0), WIN, n0, kb * 64, scr, lane); continue; }
        r -= I_IN;
        if (r < I_M) { const int nb = r % 32, kb = r / 32; transpose_item(p.w_mem, 1024, nb * 32, WM, nb * 32, kb * 64, scr, lane); continue; }
        r -= I_M;
        { const int nb = r % 64, kb = r / 64; transpose_item(p.w_out, 2048, nb * 32, WO, nb * 32, kb * 64, scr, lane); }
    }
    for (int i = blockIdx.x * NTHREADS + tid; i < 16 * DM; i += gridDim.x * NTHREADS) { const int r = i & 15, k = i >> 4; WR[r * DM + k] = (bf16_t)f2bf(p.w_in[(size_t)k * DIN + SRC_BR + r]); }
}

__device__ __forceinline__ void br_task(const bf16_t* XB, const bf16_t* WR, float* BR, int task, int wave, int lane) {
    const int fr = lane & 15, fq = lane >> 4, row0 = task * 128 + wave * 16;
    const bf16_t* ap = XB + (size_t)(row0 + fr) * DM + 8 * fq; const bf16_t* bp = WR + (size_t)fr * DM + 8 * fq;
    f32x4 acc = (f32x4){0.f, 0.f, 0.f, 0.f};
#pragma unroll 8
    for (int k0 = 0; k0 < DM; k0 += 32) { const bf16x8 a = *(const bf16x8*)(ap + k0), b = *(const bf16x8*)(bp + k0); acc = __builtin_amdgcn_mfma_f32_16x16x32_bf16(a, b, acc, 0, 0, 0); }
#pragma unroll
    for (int j = 0; j < 4; ++j) BR[(size_t)(row0 + 4 * fq + j) * 16 + fr] = acc[j];
}

__device__ __forceinline__ void mixA_task(const Params& p, LAS unsigned char* lds, int row0, int h, int L, bool write_cv) {
    int tid_ = threadIdx.x; asm volatile("" : "+v"(tid_)); const int tid = tid_, lane = tid & 63, wave = tid >> 6;
    const bf16_t* PROJ = (const bf16_t*)(p.ws + WS_PROJ); bf16_t* BRANCH = (bf16_t*)(p.ws + WS_BRANCH);
    LAS float* Wl = (LAS float*)lds;
    LAS bf16_t* vn = (LAS bf16_t*)(lds + 65536);
    LAS float* rs = (LAS float*)(lds + 65536 + 49152);
    __syncthreads();
    for (int t = wave * 16; t < wave * 16 + 16; ++t) {
        const u32x2* src = (const u32x2*)(PROJ + (size_t)(row0 + t) * DINP + C_AV) + lane; float ss = 0.f;
#pragma unroll
        for (int j = 0; j < 3; ++j) { const u32x2 w = src[64 * j]; const float a = bflo(w.x), b = bfhi(w.x), c = bflo(w.y), d = bfhi(w.y); ss += (a * a + b * b) + (c * c + d * d); }
        ss = wave_sum(ss);
        if (lane == 0) rs[t] = 1.0f / sqrtf(ss * (1.0f / 768.0f) + EPS);
    }
    for (int i = tid; i < 128 * 32; i += NTHREADS) ((LAS f32x4*)Wl)[i] = ((const f32x4*)(p.a_ws + (size_t)h * 16384))[i];
    __syncthreads();
    for (int i = tid; i < 128 * 192; i += NTHREADS) { const int t = i / 192, dd = i % 192;
        const float v = bf2f(PROJ[(size_t)(row0 + t) * DINP + C_AV + h * 192 + dd]) * rs[t] * p.a_vnorm_w[h * 192 + dd];
        vn[i] = (bf16_t)f2bf(v);
        if (write_cv) p.out[O_CV + (size_t)(row0 - NP + t) * 768 + h * 192 + dd] = v; }
    __syncthreads();
    if (tid < 384) {
        const int dd2 = tid % 96, ig = tid / 96;
        for (int k = 0; k < 32; ++k) {
            const int rl = ig + 4 * k, i = rl % L, cs = rl - i;
            float a0 = 0.f, a1 = 0.f;
            for (int j = 0; j <= i; ++j) { const float w = Wl[i * 128 + j]; const unsigned v = *(const LAS unsigned*)(vn + (cs + j) * 192 + 2 * dd2); a0 += w * bflo(v); a1 += w * bfhi(v); }
            const float bsv = p.a_bs[h * 128 + i]; a0 += bsv; a1 += bsv;
            const size_t rb = (size_t)(row0 + rl) * DINP + h * 192 + 2 * dd2;
            const unsigned uu = *(const unsigned*)(PROJ + rb + C_AU), gg = *(const unsigned*)(PROJ + rb + C_AG);
            const float o0 = bflo(uu) * a0 * silu(bflo(gg)), o1 = bfhi(uu) * a1 * silu(bfhi(gg));
            *(unsigned*)(BRANCH + (size_t)(row0 + rl) * DM + h * 192 + 2 * dd2) = pk2(o0, o1);
        }
    }
}

template <bool F32SRC>
__device__ __forceinline__ void mixX_task(const Params& p, LAS unsigned char* lds, const void* Ksrc, const void* Vsrc, int kvrow0, int h, int qrow0, int nq) {
    int tid_ = threadIdx.x; asm volatile("" : "+v"(tid_)); const int tid = tid_, lane = tid & 63, wave = tid >> 6;
    const bf16_t* PROJ = (const bf16_t*)(p.ws + WS_PROJ); bf16_t* BRANCH = (bf16_t*)(p.ws + WS_BRANCH);
    LAS unsigned char* Kl = lds;
    LAS unsigned char* Vl = lds + 69632;
    LAS float* qs = (LAS float*)(lds + 69632 + 65536) + wave * 128;
    LAS float* ps = (LAS float*)(lds + 69632 + 65536 + 4096) + wave * 256;
    __syncthreads();
    if (F32SRC) {
        const float* K = (const float*)Ksrc; const float* V = (const float*)Vsrc;
        for (int i = tid; i < 256 * 32; i += NTHREADS) { const int n = i >> 5, ch = i & 31; const size_t g = (size_t)(kvrow0 + n) * 512 + h * 128 + ch * 4;
            const f32x4 kv = *(const f32x4*)(K + g), vv = *(const f32x4*)(V + g);
            u32x2 a; a.x = pk2(kv.x, kv.y); a.y = pk2(kv.z, kv.w); *(LAS u32x2*)(Kl + n * 272 + ch * 8) = a;
            u32x2 b; b.x = pk2(vv.x, vv.y); b.y = pk2(vv.z, vv.w); *(LAS u32x2*)(Vl + n * 256 + ch * 8) = b; }
    } else {
        const bf16_t* K = (const bf16_t*)Ksrc; const bf16_t* V = (const bf16_t*)Vsrc;
        for (int i = tid; i < 256 * 16; i += NTHREADS) { const int n = i >> 4, ch = i & 15; const size_t g = (size_t)(kvrow0 + n) * 512 + h * 128 + ch * 8;
            *(LAS u32x4*)(Kl + n * 272 + ch * 16) = *(const u32x4*)(K + g); *(LAS u32x4*)(Vl + n * 256 + ch * 16) = *(const u32x4*)(V + g); }
    }
    __syncthreads();
    for (int qi = wave; qi < nq; qi += 8) {
        const int row = qrow0 + qi;
        { const unsigned w = *(const unsigned*)(PROJ + (size_t)row * DINP + C_XQ + h * 128 + 2 * lane); qs[2 * lane] = bflo(w) * 0.08838834764831845f; qs[2 * lane + 1] = bfhi(w) * 0.08838834764831845f; }
        asm volatile("s_waitcnt lgkmcnt(0)" ::: "memory");
        float s[4] = {0.f, 0.f, 0.f, 0.f};
        for (int c = 0; c < 16; ++c) {
            const f32x4 qa = *(const LAS f32x4*)(qs + 8 * c), qb = *(const LAS f32x4*)(qs + 8 * c + 4);
#pragma unroll
            for (int kk = 0; kk < 4; ++kk) { const u32x4 kv = *(const LAS u32x4*)(Kl + (lane + 64 * kk) * 272 + c * 16);
                s[kk] += (qa.x * bflo(kv.x) + qa.y * bfhi(kv.x)) + (qa.z * bflo(kv.y) + qa.w * bfhi(kv.y)) + (qb.x * bflo(kv.z) + qb.y * bfhi(kv.z)) + (qb.z * bflo(kv.w) + qb.w * bfhi(kv.w)); }
        }
        const float mx = wave_max(fmaxf(fmaxf(s[0], s[1]), fmaxf(s[2], s[3])));
        float e[4], sum = 0.f;
#pragma unroll
        for (int kk = 0; kk < 4; ++kk) { e[kk] = __expf(s[kk] - mx); sum += e[kk]; }
        const float inv = 1.0f / wave_sum(sum);
#pragma unroll
        for (int kk = 0; kk < 4; ++kk) ps[lane + 64 * kk] = e[kk] * inv;
        asm volatile("s_waitcnt lgkmcnt(0)" ::: "memory");
        float o0 = 0.f, o1 = 0.f;
        for (int n = 0; n < 256; n += 4) { const f32x4 pp = *(const LAS f32x4*)(ps + n);
#pragma unroll
            for (int j = 0; j < 4; ++j) { const unsigned v = *(const LAS unsigned*)(Vl + (n + j) * 256 + lane * 4); o0 += pp[j] * bflo(v); o1 += pp[j] * bfhi(v); } }
        const unsigned g = *(const unsigned*)(PROJ + (size_t)row * DINP + C_XG + h * 128 + 2 * lane);
        *(unsigned*)(BRANCH + (size_t)row * DM + 1536 + h * 128 + 2 * lane) = pk2(o0 * silu(bflo(g)), o1 * silu(bfhi(g)));
    }
}

__device__ __forceinline__ void mixB_task(const Params& p, LAS unsigned char* lds, int row0, int T, int h, const float* s0, float* sout) {
    int tid_ = threadIdx.x; asm volatile("" : "+v"(tid_)); const int tid = tid_, lane = tid & 63, wave = tid >> 6;
    const bf16_t* PROJ = (const bf16_t*)(p.ws + WS_PROJ); bf16_t* BRANCH = (bf16_t*)(p.ws + WS_BRANCH); const float* BR = (const float*)(p.ws + WS_BR);
    LAS float* qs = (LAS float*)lds;
    LAS float* ks = qs + 32 * 96;
    LAS float* al = ks + 32 * 96;
    LAS float* vs = al + 32 * 96;
    LAS float* po = vs + 32 * 192;
    const int e = tid % 192, hf = tid / 192, d0 = hf * 48;
    float S[48];
#pragma unroll
    for (int dd = 0; dd < 48; ++dd) S[dd] = (s0 && tid < 384) ? s0[(size_t)(d0 + dd) * 192 + e] : 0.f;
    const int TC = T < 32 ? T : 32;
    for (int t0 = 0; t0 < T; t0 += TC) {
        __syncthreads();
        for (int i = tid; i < TC * 96; i += NTHREADS) { const int t = i / 96, d = i % 96; const size_t row = (size_t)(row0 + t0 + t);
            float z = p.b_ba[h * 96 + d];
#pragma unroll
            for (int r = 0; r < 16; ++r) z += BR[row * 16 + r] * p.b_wa[r * 384 + h * 96 + d];
            const float la = (fminf(z, 0.f) - log1pf(__expf(-fabsf(z)))) * (1.0f / 16.0f);
            al[i] = __expf(la);
            qs[i] = bf2f(PROJ[row * DINP + C_BQ + h * 96 + d]) * 0.10206207261596577f;
            ks[i] = bf2f(PROJ[row * DINP + C_BK + h * 96 + d]); }
        for (int i = tid; i < TC * 192; i += NTHREADS) { const int t = i / 192, ee = i % 192; vs[i] = bf2f(PROJ[(size_t)(row0 + t0 + t) * DINP + C_BV + h * 192 + ee]); }
        __syncthreads();
        if (tid < 384) {
#pragma unroll 1
            for (int t = 0; t < TC; ++t) {
                const float v = vs[t * 192 + e]; float acc = 0.f;
#pragma unroll
                for (int d4 = 0; d4 < 12; ++d4) {
                    const f32x4 a4 = *(const LAS f32x4*)(al + t * 96 + d0 + 4 * d4), k4 = *(const LAS f32x4*)(ks + t * 96 + d0 + 4 * d4), q4 = *(const LAS f32x4*)(qs + t * 96 + d0 + 4 * d4);
#pragma unroll
                    for (int j = 0; j < 4; ++j) { S[4 * d4 + j] = a4[j] * S[4 * d4 + j] + k4[j] * v; acc += q4[j] * S[4 * d4 + j]; }
                    if ((d4 % 3) == 2) asm volatile("" ::: "memory");
                }
                po[(hf * 32 + t) * 192 + e] = acc;
            }
        }
        __syncthreads();
        for (int t = wave; t < TC; t += 8) {
            const size_t row = (size_t)(row0 + t0 + t);
            float o[3], ss = 0.f;
#pragma unroll
            for (int j = 0; j < 3; ++j) { o[j] = po[t * 192 + lane + 64 * j] + po[(32 + t) * 192 + lane + 64 * j]; ss += o[j] * o[j]; }
            const float rstd = 1.0f / sqrtf(wave_sum(ss) * (1.0f / 192.0f) + EPS);
#pragma unroll
            for (int j = 0; j < 3; ++j) { const int ee = lane + 64 * j; const float g = bf2f(PROJ[row * DINP + C_BG + h * 192 + ee]);
                BRANCH[row * DM + 768 + h * 192 + ee] = (bf16_t)f2bf(o[j] * rstd * p.b_onorm_w[ee] * silu(g)); }
        }
    }
    if (tid < 384) {
#pragma unroll
        for (int dd = 0; dd < 48; ++dd) sout[(size_t)(d0 + dd) * 192 + e] = S[dd];
    }
}


#define MFMA16(a, b, c) __builtin_amdgcn_mfma_f32_16x16x32_bf16((a), (b), (c), 0, 0, 0)
__device__ __forceinline__ void glaP_task(const Params& p, LAS unsigned char* lds, int b, int h) {
    int tid_ = threadIdx.x; asm volatile("" : "+v"(tid_)); const int tid = tid_, lane = tid & 63, w = __builtin_amdgcn_readfirstlane(tid >> 6), fr = lane & 15, fq = lane >> 4;
    LAS bf16_t* Qh  = (LAS bf16_t*)lds;
    LAS bf16_t* Kin = (LAS bf16_t*)(lds + 13312);
    LAS bf16_t* KoT = (LAS bf16_t*)(lds + 26624);
    LAS bf16_t* VT  = (LAS bf16_t*)(lds + 40448);
    LAS bf16_t* ST  = (LAS bf16_t*)(lds + 68096);
    LAS bf16_t* laH = (LAS bf16_t*)(lds + 108032);
    LAS bf16_t* laL = (LAS bf16_t*)(lds + 108032 + 13824);
    LAS bf16_t* Pm  = laH;
    LAS float* cl   = (LAS float*)(lds + 135680);
    LAS float* ssq  = (LAS float*)(lds + 136064);
    LAS float* onw  = (LAS float*)(lds + 136576);
    LAS float* bav  = (LAS float*)(lds + 137344);
    LAS unsigned char* WF = lds + 137728;
    const bf16_t* PROJ = (const bf16_t*)(p.ws + WS_PROJ); bf16_t* BRANCH = (bf16_t*)(p.ws + WS_BRANCH); const float* BR = (const float*)(p.ws + WS_BR);
    const int row0 = b * SEQ;
    const int it = w & 3, dt0 = 3 * (w >> 2);
    const int dtS0 = 3 * (w & 1), etS0 = 3 * (w >> 1);
    __syncthreads();
    if (tid < 192) { const int dt = tid >> 5, l32 = tid & 31, d = 16 * dt + (l32 & 15), r0 = 8 * (l32 >> 4); unsigned hi[8], lo[8];
#pragma unroll
        for (int jj = 0; jj < 8; ++jj) { const float wv = p.b_wa[(r0 + jj) * 384 + h * 96 + d]; hi[jj] = f2bf(wv); lo[jj] = f2bf(wv - bf2f((bf16_t)hi[jj])); }
        u32x4 a, c; a.x = hi[0] | (hi[1] << 16); a.y = hi[2] | (hi[3] << 16); a.z = hi[4] | (hi[5] << 16); a.w = hi[6] | (hi[7] << 16);
        c.x = lo[0] | (lo[1] << 16); c.y = lo[2] | (lo[3] << 16); c.z = lo[4] | (lo[5] << 16); c.w = lo[6] | (lo[7] << 16);
        *(LAS u32x4*)(WF + tid * 16) = a; *(LAS u32x4*)(WF + 3072 + tid * 16) = c; }
    for (int i = tid; i < 192; i += NTHREADS) onw[i] = p.b_onorm_w[i];
    for (int i = tid; i < 96; i += NTHREADS) bav[i] = p.b_ba[h * 96 + i];
    for (int i = tid; i < 192 * 104 / 2; i += NTHREADS) ((LAS unsigned*)ST)[i] = 0u;
    f32x4 S[3][3];
#pragma unroll
    for (int a = 0; a < 3; ++a)
#pragma unroll
        for (int e = 0; e < 3; ++e) S[a][e] = (f32x4){0.f, 0.f, 0.f, 0.f};
    const bf16_t* qkp = PROJ + (size_t)(row0 + 16 * it + fr) * DINP + C_BQ + h * 96 + 16 * dt0 + 4 * fq;
    const float* brp = BR + (size_t)(row0 + 16 * it + fr) * 16 + 8 * (fq & 1);
    const int gofs = (C_BG - C_BQ) + h * 96 + 96 * (w >> 2) - 16 * dt0;
    const int vjr = tid >> 3, vc0 = tid & 7;
    const bf16_t* vp = PROJ + (size_t)(row0 + vjr) * DINP + C_BV + h * 192 + 8 * vc0;
    u32x2 qv[3], kv[3]; f32x4 brv[2]; u32x4 vv[3];
#define GLA_LOAD_QKV(cc) do { const size_t _o = (size_t)(cc) * 64 * DINP; _Pragma("unroll") for (int n = 0; n < 3; ++n) { qv[n] = *(const u32x2*)(qkp + _o + 16 * n); kv[n] = *(const u32x2*)(qkp + _o + 384 + 16 * n); } \
        _Pragma("unroll") for (int k = 0; k < 3; ++k) vv[k] = *(const u32x4*)(vp + _o + 64 * k); } while (0)
#define GLA_LOAD_BR(cc) do { const size_t _o = (size_t)(cc) * 64 * 16; brv[0] = *(const f32x4*)(brp + _o); brv[1] = *(const f32x4*)(brp + _o + 4); } while (0)
    GLA_LOAD_BR(0); GLA_LOAD_QKV(0);
    __syncthreads();
#pragma unroll 1
    for (int c = 0; c < 32; ++c) {
        const int cn = c < 31 ? c + 1 : 31;
        {
            bf16x8 bfrag;
            const float f[8] = {brv[0].x, brv[0].y, brv[0].z, brv[0].w, brv[1].x, brv[1].y, brv[1].z, brv[1].w};
#pragma unroll
            for (int jj = 0; jj < 8; ++jj) { const unsigned hi = f2bf(f[jj]); bfrag[jj] = (fq < 2) ? (short)hi : (short)f2bf(f[jj] - bf2f((bf16_t)hi)); }
            GLA_LOAD_BR(cn);
#pragma unroll
            for (int n = 0; n < 3; ++n) {
                const int wo = ((dt0 + n) * 32 + (fq & 1) * 16 + fr) * 16;
                const bf16x8 a1 = *(const LAS bf16x8*)(WF + wo); bf16x8 a2 = *(const LAS bf16x8*)(WF + 3072 + wo);
                if (fq >= 2) a2 = (bf16x8){0, 0, 0, 0, 0, 0, 0, 0};
                f32x4 zt = MFMA16(a1, bfrag, ((f32x4){0.f, 0.f, 0.f, 0.f})); zt = MFMA16(a2, bfrag, zt);
                const f32x4 b4 = *(const LAS f32x4*)(bav + 16 * (dt0 + n) + 4 * fq);
#pragma unroll
                for (int j = 0; j < 4; ++j) { const float z = zt[j] + b4[j]; const float la = (fminf(z, 0.f) - __logf(1.0f + __expf(-fabsf(z)))) * 0.0625f;
                    const unsigned hi = f2bf(la), lo = f2bf(la - bf2f((bf16_t)hi)); const int o = (16 * (dt0 + n) + 4 * fq + j) * 72 + 16 * it + fr;
                    laH[o] = (bf16_t)hi; laL[o] = (bf16_t)lo; }
            }
        }
        __syncthreads();
        f32x4 cu[3];
#pragma unroll
        for (int n = 0; n < 3; ++n) cu[n] = (f32x4){0.f, 0.f, 0.f, 0.f};
#pragma unroll
        for (int ks = 0; ks < 2; ++ks) if (ks == 0 || it >= 2) {
            bf16x8 lt;
#pragma unroll
            for (int jj = 0; jj < 8; ++jj) lt[jj] = ((32 * ks + 8 * fq + jj) <= (16 * it + fr)) ? (short)0x3F80 : (short)0;
#pragma unroll
            for (int n = 0; n < 3; ++n) { const int o = (16 * (dt0 + n) + fr) * 72 + 32 * ks + 8 * fq;
                cu[n] = MFMA16(*(const LAS bf16x8*)(laH + o), lt, cu[n]); cu[n] = MFMA16(*(const LAS bf16x8*)(laL + o), lt, cu[n]); }
        }
        if (it == 3 && fr == 15) {
#pragma unroll
            for (int n = 0; n < 3; ++n) *(LAS f32x4*)(cl + 16 * (dt0 + n) + 4 * fq) = cu[n];
        }
        __syncthreads();
        {
            const int i = 16 * it + fr;
#pragma unroll
            for (int n = 0; n < 3; ++n) {
                const int d = 16 * (dt0 + n) + 4 * fq;
                const f32x4 clv = *(const LAS f32x4*)(cl + d);
                const float qf[4] = {bflo(qv[n].x), bfhi(qv[n].x), bflo(qv[n].y), bfhi(qv[n].y)}, kf[4] = {bflo(kv[n].x), bfhi(kv[n].x), bflo(kv[n].y), bfhi(kv[n].y)};
                float qh[4], ki[4];
#pragma unroll
                for (int j = 0; j < 4; ++j) { const float cc = cu[n][j]; qh[j] = qf[j] * 0.10206207261596577f * __expf(cc); ki[j] = kf[j] * __expf(-cc);
                    KoT[(d + j) * 72 + i] = (bf16_t)f2bf(kf[j] * __expf(clv[j] - cc)); }
                u32x2 wq, wk; wq.x = pk2(qh[0], qh[1]); wq.y = pk2(qh[2], qh[3]); wk.x = pk2(ki[0], ki[1]); wk.y = pk2(ki[2], ki[3]);
                *(LAS u32x2*)(Qh + i * 104 + d) = wq; *(LAS u32x2*)(Kin + i * 104 + d) = wk;
            }
#pragma unroll
            for (int k = 0; k < 3; ++k) { const unsigned ww[4] = {vv[k].x, vv[k].y, vv[k].z, vv[k].w}; LAS bf16_t* vt = VT + (8 * (vc0 + 8 * k)) * 72 + vjr;
#pragma unroll
                for (int q = 0; q < 4; ++q) { vt[(2 * q) * 72] = (bf16_t)(ww[q] & 0xffffu); vt[(2 * q + 1) * 72] = (bf16_t)(ww[q] >> 16); } }
            GLA_LOAD_QKV(cn);
        }
        __syncthreads();
        {
            const int ita = w >> 1;
#pragma unroll
            for (int j2 = 0; j2 < 2; ++j2) { const int jt = 2 * (w & 1) + j2; u32x2 wp; wp.x = 0u; wp.y = 0u;
                if (jt <= ita) { f32x4 pt = (f32x4){0.f, 0.f, 0.f, 0.f};
#pragma unroll
                    for (int ks = 0; ks < 3; ++ks) pt = MFMA16(*(const LAS bf16x8*)(Kin + (16 * jt + fr) * 104 + 32 * ks + 8 * fq), *(const LAS bf16x8*)(Qh + (16 * ita + fr) * 104 + 32 * ks + 8 * fq), pt);
                    if (jt == ita) {
#pragma unroll
                        for (int j = 0; j < 4; ++j) if (4 * fq + j > fr) pt[j] = 0.f; }
                    wp.x = pk2(pt[0], pt[1]); wp.y = pk2(pt[2], pt[3]); }
                *(LAS u32x2*)(Pm + (16 * ita + fr) * 72 + 16 * jt + 4 * fq) = wp; }
        }
        __syncthreads();
        f32x4 oacc[6]; u32x2 gv[6];
        {
            { const bf16_t* gp = qkp + (size_t)c * 64 * DINP + gofs;
#pragma unroll
              for (int m = 0; m < 6; ++m) gv[m] = *(const u32x2*)(gp + 16 * m); }
            bf16x8 bP0, bP1, bQ[3];
            bP0 = *(const LAS bf16x8*)(Pm + (16 * it + fr) * 72 + 8 * fq); bP1 = *(const LAS bf16x8*)(Pm + (16 * it + fr) * 72 + 32 + 8 * fq);
#pragma unroll
            for (int ks = 0; ks < 3; ++ks) bQ[ks] = *(const LAS bf16x8*)(Qh + (16 * it + fr) * 104 + 32 * ks + 8 * fq);
            const LAS bf16_t* vtb = VT + (96 * (w >> 2) + fr) * 72 + 8 * fq; const LAS bf16_t* stb = ST + (96 * (w >> 2) + fr) * 104 + 8 * fq;
#pragma unroll
            for (int m = 0; m < 6; ++m) {
                f32x4 o = MFMA16(*(const LAS bf16x8*)(vtb + m * 16 * 72), bP0, ((f32x4){0.f, 0.f, 0.f, 0.f}));
                if (it >= 2) o = MFMA16(*(const LAS bf16x8*)(vtb + m * 16 * 72 + 32), bP1, o);
#pragma unroll
                for (int ks = 0; ks < 3; ++ks) o = MFMA16(*(const LAS bf16x8*)(stb + m * 16 * 104 + 32 * ks), bQ[ks], o);
                oacc[m] = o; }
            float ss = 0.f;
#pragma unroll
            for (int m = 0; m < 6; ++m) ss += (oacc[m][0] * oacc[m][0] + oacc[m][1] * oacc[m][1]) + (oacc[m][2] * oacc[m][2] + oacc[m][3] * oacc[m][3]);
            ss += __shfl_xor(ss, 16); ss += __shfl_xor(ss, 32);
            if (fq == 0) ssq[(16 * it + fr) * 2 + (w >> 2)] = ss;
#pragma unroll
            for (int a = 0; a < 3; ++a) { const f32x4 gl = *(const LAS f32x4*)(cl + 16 * (dtS0 + a) + 4 * fq); f32x4 g4;
#pragma unroll
                for (int j = 0; j < 4; ++j) g4[j] = __expf(gl[j]);
#pragma unroll
                for (int e = 0; e < 3; ++e) S[a][e] = S[a][e] * g4; }
            const LAS bf16_t* kob = KoT + (16 * dtS0 + fr) * 72 + 8 * fq; const LAS bf16_t* vsb = VT + (16 * etS0 + fr) * 72 + 8 * fq;
#pragma unroll
            for (int ks = 0; ks < 2; ++ks) { bf16x8 aK[3], bV[3];
#pragma unroll
                for (int a = 0; a < 3; ++a) aK[a] = *(const LAS bf16x8*)(kob + a * 16 * 72 + 32 * ks);
#pragma unroll
                for (int e = 0; e < 3; ++e) bV[e] = *(const LAS bf16x8*)(vsb + e * 16 * 72 + 32 * ks);
#pragma unroll
                for (int a = 0; a < 3; ++a)
#pragma unroll
                    for (int e = 0; e < 3; ++e) S[a][e] = MFMA16(aK[a], bV[e], S[a][e]); }
        }
        __syncthreads();
#pragma unroll
        for (int a = 0; a < 3; ++a)
#pragma unroll
            for (int e = 0; e < 3; ++e) { u32x2 ws_; ws_.x = pk2(S[a][e][0], S[a][e][1]); ws_.y = pk2(S[a][e][2], S[a][e][3]); *(LAS u32x2*)(ST + (16 * (etS0 + e) + fr) * 104 + 16 * (dtS0 + a) + 4 * fq) = ws_; }
        {
            const int i = 16 * it + fr; const f32x2 sp = *(const LAS f32x2*)(ssq + 2 * i);
            const float rstd = 1.0f / sqrtf((sp.x + sp.y) * (1.0f / 192.0f) + EPS);
            bf16_t* orow = BRANCH + (size_t)(row0 + 64 * c + i) * DM + 768 + h * 192 + 96 * (w >> 2) + 4 * fq;
#pragma unroll
            for (int m = 0; m < 6; ++m) { const f32x4 ow = *(const LAS f32x4*)(onw + 96 * (w >> 2) + 16 * m + 4 * fq);
                const float g0 = bflo(gv[m].x), g1 = bfhi(gv[m].x), g2 = bflo(gv[m].y), g3 = bfhi(gv[m].y);
                u32x2 wo; wo.x = pk2(oacc[m][0] * rstd * ow[0] * silu(g0), oacc[m][1] * rstd * ow[1] * silu(g1)); wo.y = pk2(oacc[m][2] * rstd * ow[2] * silu(g2), oacc[m][3] * rstd * ow[3] * silu(g3));
                *(u32x2*)(orow + 16 * m) = wo; }
        }
    }
    float* so = p.out + O_SP + (size_t)(b * 4 + h) * 96 * 192;
#pragma unroll
    for (int a = 0; a < 3; ++a)
#pragma unroll
        for (int e = 0; e < 3; ++e)
#pragma unroll
            for (int j = 0; j < 4; ++j) so[(size_t)(16 * (dtS0 + a) + 4 * fq + j) * 192 + 16 * (etS0 + e) + fr] = S[a][e][j];
#undef GLA_LOAD_QKV
#undef GLA_LOAD_BR
}

__device__ __forceinline__ void phase_mix(const Params& p, LAS unsigned char* lds) {
    const int G = gridDim.x, c = blockIdx.x;
    const int NBP = 16, NBS = 512, NA = 256 + 32, NXP = 256, NXS = 512, NTASK = NBP + NBS + NA + NXP + NXS;
    for (int t = c; t < NTASK; t += G) {
        int r = t;
        if (r < NBP + NBS) {
            int row0, T, h; const float* s0; float* so;
            if (r < NBP) { glaP_task(p, lds, r >> 2, r & 3); continue; }
            { const int q = r - NBP, b = q >> 2; h = q & 3; row0 = NP + b * 8; T = 8; s0 = p.state + (size_t)(b * 4 + h) * 96 * 192; so = p.out + O_SS + (size_t)(b * 4 + h) * 96 * 192; }
            mixB_task(p, lds, row0, T, h, s0, so); continue; }
        r -= NBP + NBS;
        if (r < NA) { const int h = r & 3, blk = r >> 2; const bool smp = r >= 256; mixA_task(p, lds, smp ? NP + (blk - 64) * 128 : blk * 128, h, smp ? 8 : 128, smp); continue; }
        r -= NA;
        if (r < NXP) { const int qt = r & 15, h = (r >> 4) & 3, b = r >> 6; mixX_task<false>(p, lds, p.ws + WS_MKB, p.ws + WS_MVB, b * 256, h, b * SEQ + qt * 128, 128); continue; }
        r -= NXP;
        { const int h = r & 3, b = r >> 2; mixX_task<true>(p, lds, p.cache_k, p.cache_v, b * 256, h, NP + b * 8, 8); }
    }
}

__device__ __forceinline__ void phase_final(const Params& p) {
    const int lane = threadIdx.x & 63, wave = threadIdx.x >> 6;
    const int gw = blockIdx.x * 8 + wave, NGW = gridDim.x * 8;
    for (int r = gw; r < NTOK; r += NGW) {
        f32x4* s = (f32x4*)(p.out + (size_t)r * DM) + lane; const f32x4* wv = (const f32x4*)p.final_w + lane;
        f32x4 v[8]; float ss = 0.f;
#pragma unroll
        for (int j = 0; j < 8; ++j) { v[j] = s[64 * j]; ss += (v[j].x * v[j].x + v[j].y * v[j].y) + (v[j].z * v[j].z + v[j].w * v[j].w); }
        const float rstd = 1.0f / sqrtf(wave_sum(ss) * (1.0f / DM) + EPS);
#pragma unroll
        for (int j = 0; j < 8; ++j) { const f32x4 ww = wv[64 * j]; s[64 * j] = v[j] * rstd * ww; }
    }
}


#define XB_TMO      128
#define XB_XCNT(j)  (256  + 64 * (j))
#define XB_XSUB(j)  (1280 + 64 * (j))
#define XB_XGEN(j)  (2304 + 64 * (j))
#define XB_TOP      3328
#define XB_TOPGEN   3392
#define XCD_BAR_WORDS 3456
#define XB_SPIN_CAP (1u << 18)
__device__ __forceinline__ unsigned xb_ld(unsigned* p)              { return __hip_atomic_load(p, __ATOMIC_RELAXED, __HIP_MEMORY_SCOPE_AGENT); }
__device__ __forceinline__ unsigned xb_add(unsigned* p, unsigned v) { return __hip_atomic_fetch_add(p, v, __ATOMIC_RELAXED, __HIP_MEMORY_SCOPE_AGENT); }
__device__ __forceinline__ unsigned xb_xcc_id() { return (unsigned)__builtin_amdgcn_s_getreg((3 << 11) | 20) & 0xFu; }
#define XB_SPIN(cond, bar) do { unsigned _sp = 0; while (cond) { __builtin_amdgcn_s_sleep(1); \
    if ((++_sp & 255u) == 0u) { if (xb_ld(&(bar)[XB_TMO])) break; if (_sp > XB_SPIN_CAP) { atomicAdd(&(bar)[XB_TMO], 1u); break; } } } } while (0)
struct XcdBarrier { unsigned* bar; unsigned x; volatile LAS unsigned* st; };
__device__ __forceinline__ XcdBarrier xcd_barrier_post(unsigned* bar, volatile LAS unsigned* st) {
    XcdBarrier b; b.bar = bar; b.x = xb_xcc_id(); b.st = st;
    if (threadIdx.x == 0) (void)xb_add(&bar[XB_XCNT(b.x)], 1u);
    return b;
}
__device__ __forceinline__ void xcd_barrier_complete(unsigned* bar, unsigned x, unsigned& nloc, unsigned& nx) {
    const unsigned G = gridDim.x * gridDim.y * gridDim.z;
    unsigned sum, cnt, mine, sp = 0u;
    for (;;) {
        sum = 0u; cnt = 0u; mine = 0u;
#pragma unroll
        for (unsigned j = 0; j < 16; ++j) { const unsigned c = xb_ld(&bar[XB_XCNT(j)]); sum += c; cnt += (c > 0u) ? 1u : 0u; mine = (j == x) ? c : mine; }
        if (sum == G) break;
        __builtin_amdgcn_s_sleep(1);
        if ((++sp & 255u) == 0u) { if (xb_ld(&bar[XB_TMO])) break; if (sp > XB_SPIN_CAP) { atomicAdd(&bar[XB_TMO], 1u); break; } }
    }
    nloc = mine > 0u ? mine : 1u; nx = cnt > 0u ? cnt : 1u;
}
__device__ __forceinline__ void xcd_barrier(const XcdBarrier& b) {
    asm volatile("s_waitcnt vmcnt(0)" ::: "memory");
    __syncthreads();
    if (threadIdx.x == 0) {
        unsigned* bar = b.bar;
        __builtin_amdgcn_s_waitcnt(0);
        unsigned nloc = b.st[0], nx = b.st[1];
        if (nloc == 0u) { xcd_barrier_complete(bar, b.x, nloc, nx); b.st[0] = nloc; b.st[1] = nx; }
        const unsigned old = xb_add(&bar[XB_XSUB(b.x)], 1u);
        const unsigned gen = old / nloc;
        if (old + 1u == (gen + 1u) * nloc) {
            __builtin_amdgcn_fence(__ATOMIC_RELEASE, "agent");
            asm volatile("s_waitcnt vmcnt(0)" ::: "memory");
            const unsigned og = xb_add(&bar[XB_TOP], 1u);
            const unsigned tg = og / nx;
            if (og + 1u == (tg + 1u) * nx) xb_add(&bar[XB_TOPGEN], 1u);
            else XB_SPIN(xb_ld(&bar[XB_TOPGEN]) == tg, bar);
            __builtin_amdgcn_fence(__ATOMIC_ACQUIRE, "agent");
            xb_add(&bar[XB_XGEN(b.x)], 1u);
            asm volatile("s_waitcnt vmcnt(0)" ::: "memory");
        } else {
            XB_SPIN(xb_ld(&bar[XB_XGEN(b.x)]) == gen, bar);
            __builtin_amdgcn_fence(__ATOMIC_ACQUIRE, "agent");
            asm volatile("s_waitcnt vmcnt(0)" ::: "memory");
        }
    }
    __syncthreads();
}

__global__ void __launch_bounds__(NTHREADS, 2) fwd(Params p) {
    extern __shared__ __attribute__((aligned(16))) unsigned char lds_raw[];
    LAS unsigned char* lds = (LAS unsigned char*)lds_raw;
    const int lo = p.ph_lo, hi = p.ph_hi;
    volatile LAS unsigned* MISC = (volatile LAS unsigned*)(lds + LDS_MISC);
    if (threadIdx.x < 64) MISC[threadIdx.x] = 0u;
    __syncthreads();
    XcdBarrier bar; bar.bar = (unsigned*)(p.ws + WS_CTL) + 4096; bar.x = 0; bar.st = nullptr;
    if (hi - lo > 1) bar = xcd_barrier_post((unsigned*)(p.ws + WS_CTL) + 4096, MISC + 8);
#define BOTH(k) (IN(k) && IN((k) + 1))
#ifndef PH_MASK
#define PH_MASK 31
#endif
#define IN(k) (((PH_MASK >> (k)) & 1) && lo <= (k) && (k) < hi)
    if (IN(0)) { phase_prep(p, lds); if (BOTH(0)) xcd_barrier(bar); }
    if (IN(1)) {
        Prog1 P; P.XB = (const char*)(p.ws + WS_XB); P.WIN = (const char*)(p.ws + WS_WIN); P.MB = (const char*)(p.ws + WS_MB); P.WM = (const char*)(p.ws + WS_WM);
        P.PROJ = (bf16_t*)(p.ws + WS_PROJ); P.out = p.out; P.MKB = (bf16_t*)(p.ws + WS_MKB); P.MVB = (bf16_t*)(p.ws + WS_MVB); P.G = gridDim.x; P.c = blockIdx.x;
        pg8::gemm_phase(lds, P);
        const int wave = threadIdx.x >> 6, lane = threadIdx.x & 63;
        for (int t = (blockIdx.x + gridDim.x - 40) % gridDim.x; t < 72; t += gridDim.x) br_task((const bf16_t*)(p.ws + WS_XB), (const bf16_t*)(p.ws + WS_WR), (float*)(p.ws + WS_BR), t, wave, lane);
        if (BOTH(1)) xcd_barrier(bar);
    }
    if (IN(2)) { phase_mix(p, lds); if (BOTH(2)) xcd_barrier(bar); }
    if (IN(3)) {
        Prog3 P; P.BRANCH = (const char*)(p.ws + WS_BRANCH); P.WO = (const char*)(p.ws + WS_WO); P.xp = p.x_prompt; P.xs = p.x_sample; P.out = p.out; P.G = gridDim.x; P.c = blockIdx.x;
        pg8::gemm_phase(lds, P);
        if (BOTH(3)) xcd_barrier(bar);
    }
    if (IN(4)) phase_final(p);
#undef IN
#undef BOTH
}

extern "C" void kernel_launch(void* const* d_in, const int* in_sizes, int n_in, void* d_out, int out_size, void* d_ws, size_t ws_size, hipStream_t stream) {
    static int grid = 0;
    if (grid == 0) {
        if (n_in != 18 || ws_size < WS_END) { fprintf(stderr, "kernel_launch: unexpected n_in %d or ws_size %zu\n", n_in, ws_size); grid = -1; return; }
        int dev = 0, cus = 0;
        if (hipGetDevice(&dev) != hipSuccess || hipDeviceGetAttribute(&cus, hipDeviceAttributeMultiprocessorCount, dev) != hipSuccess) { grid = -1; return; }
        if (hipFuncSetAttribute((const void*)fwd, hipFuncAttributeMaxDynamicSharedMemorySize, LDS_BYTES) != hipSuccess) { fprintf(stderr, "kernel_launch: hipFuncSetAttribute failed\n"); grid = -1; return; }
        grid = cus > 0 ? cus : 256;
    }
    if (grid < 0) return;
    Params p{};
    const float** pp = (const float**)&p;
    for (int i = 0; i < 18; ++i) pp[i] = (const float*)d_in[i];
    p.out = (float*)d_out; p.ws = (unsigned char*)d_ws;
    (void)hipMemsetAsync((char*)d_ws + WS_CTL, 0, 65536, stream);
#if N_LAUNCH_MODE == 1
    p.ph_lo = 0; p.ph_hi = 5; hipLaunchKernelGGL(fwd, dim3(grid), dim3(NTHREADS), LDS_BYTES, stream, p);
#else
    for (int ph = 0; ph < 5; ++ph) { p.ph_lo = ph; p.ph_hi = ph + 1; hipLaunchKernelGGL(fwd, dim3(grid), dim3(NTHREADS), LDS_BYTES, stream, p); }
#endif
}
```

```cpp
#include <hip/hip_runtime.h>
#include <cstdio>
#include <cstdint>

#define LAS __attribute__((address_space(3)))
typedef unsigned short bf16_t;
typedef short bf16x8 __attribute__((ext_vector_type(8)));
typedef float f32x4 __attribute__((ext_vector_type(4)));
typedef float f32x2 __attribute__((ext_vector_type(2)));
typedef unsigned u32x4 __attribute__((ext_vector_type(4)));
typedef unsigned u32x2 __attribute__((ext_vector_type(2)));

#define USE_A2 1
#define USE_XP 1
#define USE_XS 1
#ifndef N_LAUNCH_MODE
#define N_LAUNCH_MODE 1
#endif

constexpr int DM = 2048;
constexpr int NP = 8192, NS = 1024, NTOK = NP + NS, NMR = 1024;
constexpr int SEQ = 2048, DSEQ = 8, NB = 4, DB = 128, NMEM = 256;
constexpr int DIN = 5648, DINP = 5632;
constexpr int C_AU = 0, C_AV = 768, C_AG = 1536, C_BQ = 2304, C_BK = 2688, C_BV = 3072, C_BG = 3840, C_XQ = 4608, C_XG = 5120;
constexpr int SRC_BR = 3840;
constexpr float EPS = 1e-6f;
constexpr size_t O_Y = 0, O_MK = 18874368, O_MV = 19398656, O_SP = 19922944, O_SS = 20217856, O_CV = 29655040;
constexpr size_t MiB = 1u << 20;
constexpr size_t WS_CTL = 0, CTL_BYTES = 1 * MiB;
constexpr size_t WS_XB = 2 * MiB, WS_MB = 38 * MiB, WS_WIN = 42 * MiB, WS_WM = 64 * MiB, WS_WO = 68 * MiB, WS_WR = 76 * MiB, WS_BR = 77 * MiB,
                 WS_MKB = 78 * MiB, WS_MVB = 79 * MiB, WS_PROJ = 80 * MiB, WS_BRANCH = 180 * MiB, WS_END = 216 * MiB;
constexpr int LDS_MISC = 147456;
constexpr int LDS_BYTES = 148480;
constexpr int NTHREADS = 512;

struct Params {
    const float *x_prompt, *x_sample, *mem, *state, *cache_k, *cache_v, *norm_w, *w_in, *a_vnorm_w, *a_ws, *a_bs, *b_wa, *b_ba, *b_onorm_w,
                *mem_norm_w, *w_mem, *w_out, *final_w;
    float* out; unsigned char* ws;
    int ph_lo, ph_hi;
};

typedef __bf16 bf16x2_t __attribute__((ext_vector_type(2)));
__device__ __forceinline__ unsigned cvt_pk_bf16(float lo, float hi) { const f32x2 v = {lo, hi}; const bf16x2_t b = __builtin_convertvector(v, bf16x2_t); return __builtin_bit_cast(unsigned, b); }
__device__ __forceinline__ unsigned pk2(float lo, float hi) { return cvt_pk_bf16(lo, hi); }
__device__ __forceinline__ unsigned f2bf(float f) { return cvt_pk_bf16(f, 0.f) & 0xffffu; }
__device__ __forceinline__ float bflo(unsigned w) { return __builtin_bit_cast(float, w << 16); }
__device__ __forceinline__ float bfhi(unsigned w) { return __builtin_bit_cast(float, w & 0xffff0000u); }
__device__ __forceinline__ float bf2f(bf16_t b) { return __builtin_bit_cast(float, ((unsigned)b) << 16); }
__device__ __forceinline__ float wave_sum(float v) {
#pragma unroll
    for (int o = 1; o < 64; o <<= 1) v += __shfl_xor(v, o);
    return v;
}
__device__ __forceinline__ float wave_max(float v) {
#pragma unroll
    for (int o = 1; o < 64; o <<= 1) v = fmaxf(v, __shfl_xor(v, o));
    return v;
}
__device__ __forceinline__ float silu(float x) { return x * __builtin_amdgcn_rcpf(1.0f + __expf(-x)); }


typedef short s16x4 __attribute__((ext_vector_type(4)));
__device__ __forceinline__ s16x4 tr_read(unsigned addr) { s16x4 r; asm volatile("ds_read_b64_tr_b16 %0, %1" : "=&v"(r) : "v"(addr) : "memory"); return r; }
#define TR_WAIT() do { asm volatile("s_waitcnt lgkmcnt(0)" ::: "memory"); __builtin_amdgcn_sched_barrier(0); } while (0)
#define PK8(L, H) ((bf16x8){(L)[0], (L)[1], (L)[2], (L)[3], (H)[0], (H)[1], (H)[2], (H)[3]})
#define LBAR() do { asm volatile("s_waitcnt lgkmcnt(0)" ::: "memory"); __builtin_amdgcn_s_barrier(); asm volatile("" ::: "memory"); } while (0)
#define MFMA16(a, b, c) __builtin_amdgcn_mfma_f32_16x16x32_bf16((a), (b), (c), 0, 0, 0)

namespace pg8 {
constexpr int BM = 256, BK = 64, HALF = 128, HTB = HALF * BK * 2, STAGE_BYTES = 8 * HTB, NXCD = 8, WGM = 8;
constexpr int K = DM, NT = K / BK;
constexpr size_t TSTEP = (size_t)BM * K * 2;
__device__ __forceinline__ int lds_byte(int r, int c) { const int st = (r >> 4) * 2 + (c >> 5), rr = r & 15, cc = c & 31, ob = rr * 64 + cc * 2; return st * 1024 + (ob ^ (((ob >> 9) & 1) << 5)); }
__device__ __forceinline__ void stage_rc(int b, int& R, int& C) { const int st = b / 1024, sb = b % 1024, swz = sb ^ (((sb >> 9) & 1) << 5); R = (st >> 1) * 16 + swz / 64; C = (st & 1) * 32 + (swz % 64) / 2; }
__device__ __forceinline__ int perm32(int rho) { const int n = rho >> 4, i = rho & 15; return 8 * (i >> 2) + 4 * n + (i & 3); }
struct Unit { int pm, pn, kind; };
__device__ __forceinline__ void static_tile(int L, int nM, int nN, int& pm, int& pn) {
    const int nwg = nM * nN; int wgid = L; { const int q = nwg / NXCD, r = nwg % NXCD, xcd = wgid % NXCD, off = wgid / NXCD; wgid = (xcd < r ? xcd * (q + 1) : r * (q + 1) + (xcd - r) * q) + off; }
    const int nig = WGM * nN, gid = wgid / nig, fm = gid * WGM, gsz = (nM - fm) < WGM ? (nM - fm) : WGM;
    pm = fm + ((wgid % nig) % gsz); pn = (wgid % nig) / gsz;
}
typedef f32x4 Acc[2][2][4][2];

template <class Prog>
__device__ __forceinline__ void gemm_phase(LAS unsigned char* lds, const Prog& P) {
    const int tid = threadIdx.x, wid = __builtin_amdgcn_readfirstlane(tid >> 6), lane = tid & 63, wr = wid >> 2, wc = wid & 3, fr = lane & 15, fq = lane >> 4;
    unsigned voffA[2], voffB[2];
#pragma unroll
    for (int i = 0; i < 2; ++i) { int R, C; stage_rc(tid * 16 + i * 8192, R, C); const int Rb = (R & ~31) + perm32(R & 31);
        voffA[i] = (unsigned)(R * K + C) * 2u; voffB[i] = (unsigned)(Rb * K + C) * 2u; }
    const size_t kstep = (size_t)(BK * 2);
    const size_t hstep = (size_t)HALF * K * 2;
    const unsigned ldsw = (unsigned)wid * 1024u;
    const int aoff = lds_byte(wr * 64 + fr, fq * 8), boff = lds_byte(wc * 32 + fr, fq * 8);
#define PG8_SA(b, h) (((b) * 2 + (h)) * HTB)
#define PG8_SB(b, h) ((4 + (b) * 2 + (h)) * HTB)
#define PG8_STAGE(bufoff, gbase, voff) do { _Pragma("unroll") for (int _i = 0; _i < 2; ++_i) \
        __builtin_amdgcn_global_load_lds((const unsigned*)((const char*)(gbase) + (voff)[_i]), (LAS unsigned*)(lds + (bufoff) + ldsw + _i * 8192), 16, 0, 0); } while (0)
#define PG8_LDA(dst, b, h) do { _Pragma("unroll") for (int m = 0; m < 4; ++m) _Pragma("unroll") for (int k = 0; k < 2; ++k) dst[m][k] = *(const LAS bf16x8*)(lds + PG8_SA(b, h) + aoff + m * 2048 + k * 1024); } while (0)
#define PG8_LDB(dst, b, h) do { _Pragma("unroll") for (int n = 0; n < 2; ++n) _Pragma("unroll") for (int k = 0; k < 2; ++k) dst[n][k] = *(const LAS bf16x8*)(lds + PG8_SB(b, h) + boff + n * 2048 + k * 1024); } while (0)
#define PG8_MMA(ai, bj, At, Bt) do { __builtin_amdgcn_s_setprio(1); _Pragma("unroll") for (int m = 0; m < 4; ++m) _Pragma("unroll") for (int n = 0; n < 2; ++n) _Pragma("unroll") for (int k = 0; k < 2; ++k) \
        acc[ai][bj][m][n] = __builtin_amdgcn_mfma_f32_16x16x32_bf16(Bt[n][k], At[m][k], acc[ai][bj][m][n], 0, 0, 0); __builtin_amdgcn_s_setprio(0); } while (0)
#define PG8_WAIT_V(n) asm volatile("s_waitcnt vmcnt(" #n ")" ::: "memory")
#define PG8_WAIT_L(n) asm volatile("s_waitcnt lgkmcnt(" #n ")" ::: "memory")
#define PG8_BAR __builtin_amdgcn_s_barrier()
#define PG8_SCHED __builtin_amdgcn_sched_barrier(0)
    Unit cur, nxt; int ui = 0;
    if (!P.next(0, cur)) return;
    Acc acc;
#pragma unroll
    for (int a = 0; a < 2; ++a)
#pragma unroll
        for (int b = 0; b < 2; ++b)
#pragma unroll
            for (int m = 0; m < 4; ++m)
#pragma unroll
                for (int n = 0; n < 2; ++n) acc[a][b][m][n] = (f32x4){0.f, 0.f, 0.f, 0.f};
    bf16x8 At[4][2], B0[2][2], B1[2][2];
    const char* cA = P.a_ptr(cur); const char* cB = P.b_ptr(cur);
    PG8_STAGE(PG8_SB(0, 0), cB, voffB); PG8_STAGE(PG8_SA(0, 0), cA, voffA); PG8_STAGE(PG8_SB(0, 1), cB + hstep, voffB); PG8_STAGE(PG8_SA(0, 1), cA + hstep, voffA);
    if (wr == 1) PG8_BAR;
    PG8_WAIT_V(4); PG8_BAR;
    PG8_STAGE(PG8_SB(1, 0), cB + kstep, voffB); PG8_STAGE(PG8_SA(1, 0), cA + kstep, voffA); PG8_STAGE(PG8_SB(1, 1), cB + hstep + kstep, voffB);
    PG8_WAIT_V(6); PG8_BAR;
    for (;;) {
        const bool has_next = P.next(ui + 1, nxt);
        const char* nA = has_next ? P.a_ptr(nxt) : cA; const char* nB = has_next ? P.b_ptr(nxt) : cB;
        for (int t = 0; t < NT; t += 2) {
            const bool last = (t == NT - 2);
            const char* a1 = cA + (size_t)(t + 1) * kstep;
            const char* a2 = last ? nA : cA + (size_t)(t + 2) * kstep; const char* b2 = last ? nB : cB + (size_t)(t + 2) * kstep;
            const char* a3 = a2 + kstep; const char* b3 = b2 + kstep;
            PG8_LDB(B0, 0, 0); PG8_SCHED; PG8_LDA(At, 0, 0); PG8_STAGE(PG8_SA(1, 1), a1 + hstep, voffA);
            PG8_WAIT_L(8); PG8_BAR; PG8_WAIT_L(0); PG8_MMA(0, 0, At, B0); PG8_BAR; PG8_SCHED;
            PG8_LDB(B1, 0, 1); PG8_STAGE(PG8_SB(0, 0), b2, voffB);
            PG8_BAR; PG8_WAIT_L(0); PG8_MMA(0, 1, At, B1); PG8_BAR;
            PG8_LDA(At, 0, 1); PG8_STAGE(PG8_SA(0, 0), a2, voffA);
            PG8_BAR; PG8_WAIT_L(0); PG8_MMA(1, 0, At, B0); PG8_BAR; PG8_SCHED;
            PG8_STAGE(PG8_SB(0, 1), b2 + hstep, voffB);
            PG8_WAIT_V(6); PG8_BAR; PG8_MMA(1, 1, At, B1); PG8_BAR;
            PG8_LDB(B0, 1, 0); PG8_SCHED; PG8_LDA(At, 1, 0); PG8_STAGE(PG8_SA(0, 1), a2 + hstep, voffA);
            PG8_WAIT_L(8); PG8_BAR; PG8_WAIT_L(0); PG8_MMA(0, 0, At, B0); PG8_BAR; PG8_SCHED;
            PG8_LDB(B1, 1, 1); PG8_STAGE(PG8_SB(1, 0), b3, voffB);
            PG8_BAR; PG8_WAIT_L(0); PG8_MMA(0, 1, At, B1); PG8_BAR;
            PG8_LDA(At, 1, 1); PG8_STAGE(PG8_SA(1, 0), a3, voffA);
            PG8_BAR; PG8_WAIT_L(0); PG8_MMA(1, 0, At, B0); PG8_BAR; PG8_SCHED;
            PG8_STAGE(PG8_SB(1, 1), b3 + hstep, voffB);
            PG8_WAIT_V(6); PG8_BAR; PG8_MMA(1, 1, At, B1); PG8_BAR;
        }
        P.epi(acc, cur, wr, wc, fr, fq);
        if (!has_next) break;
#pragma unroll
        for (int a = 0; a < 2; ++a)
#pragma unroll
            for (int b = 0; b < 2; ++b)
#pragma unroll
                for (int m = 0; m < 4; ++m)
#pragma unroll
                    for (int n = 0; n < 2; ++n) acc[a][b][m][n] = (f32x4){0.f, 0.f, 0.f, 0.f};
        cur = nxt; cA = nA; cB = nB; ++ui;
    }
    PG8_WAIT_V(0);
    if (wr == 0) PG8_BAR;
    PG8_BAR;
#undef PG8_SA
#undef PG8_SB
#undef PG8_STAGE
#undef PG8_LDA
#undef PG8_LDB
#undef PG8_MMA
#undef PG8_WAIT_V
#undef PG8_WAIT_L
#undef PG8_BAR
#undef PG8_SCHED
}
}

struct Prog1 {
    const char *XB, *WIN, *MB, *WM; bf16_t* PROJ; float* out; bf16_t *MKB, *MVB; int G, c;
    __device__ __forceinline__ bool next(int i, pg8::Unit& u) const {
        const int L = i * G + c; if (L >= 808) return false;
        if (L < 792) { pg8::static_tile(L, 36, 22, u.pm, u.pn); u.kind = 0; } else { const int r = L - 792; u.pm = r >> 2; u.pn = r & 3; u.kind = 1; }
        return true;
    }
    __device__ __forceinline__ const char* a_ptr(const pg8::Unit& u) const { return (u.kind == 0 ? XB : MB) + (size_t)u.pm * pg8::TSTEP; }
    __device__ __forceinline__ const char* b_ptr(const pg8::Unit& u) const { return (u.kind == 0 ? WIN : WM) + (size_t)u.pn * pg8::TSTEP; }
    __device__ __forceinline__ void epi(const pg8::Acc& acc, const pg8::Unit& u, int wr, int wc, int fr, int fq) const {
        const int row0 = u.pm * 256 + wr * 64 + fr;
        if (u.kind == 0) {
            const int col0 = u.pn * 256 + wc * 32 + 8 * fq;
#pragma unroll
            for (int ai = 0; ai < 2; ++ai)
#pragma unroll
                for (int m = 0; m < 4; ++m) { bf16_t* rowp = PROJ + (size_t)(row0 + ai * 128 + m * 16) * DINP + col0;
#pragma unroll
                    for (int bj = 0; bj < 2; ++bj) { const f32x4 v0 = acc[ai][bj][m][0], v1 = acc[ai][bj][m][1];
                        u32x4 w; w.x = cvt_pk_bf16(v0[0], v0[1]); w.y = cvt_pk_bf16(v0[2], v0[3]); w.z = cvt_pk_bf16(v1[0], v1[1]); w.w = cvt_pk_bf16(v1[2], v1[3]);
                        *(u32x4*)(rowp + bj * 128) = w; } }
        } else {
            const int col0 = (u.pn & 1) * 256 + wc * 32 + 8 * fq;
            float* dst = out + (u.pn < 2 ? O_MK : O_MV); bf16_t* dstb = (u.pn < 2 ? MKB : MVB);
#pragma unroll
            for (int ai = 0; ai < 2; ++ai)
#pragma unroll
                for (int m = 0; m < 4; ++m) { const size_t off = (size_t)(row0 + ai * 128 + m * 16) * 512 + col0;
#pragma unroll
                    for (int bj = 0; bj < 2; ++bj) { const f32x4 v0 = acc[ai][bj][m][0], v1 = acc[ai][bj][m][1];
                        *(f32x4*)(dst + off + bj * 128) = v0; *(f32x4*)(dst + off + bj * 128 + 4) = v1;
                        u32x4 w; w.x = cvt_pk_bf16(v0[0], v0[1]); w.y = cvt_pk_bf16(v0[2], v0[3]); w.z = cvt_pk_bf16(v1[0], v1[1]); w.w = cvt_pk_bf16(v1[2], v1[3]);
                        *(u32x4*)(dstb + off + bj * 128) = w; } }
        }
    }
};
struct Prog3 {
    const char *BRANCH, *WO; const float *xp, *xs; float* out; int G, c;
    __device__ __forceinline__ bool next(int i, pg8::Unit& u) const {
        const int L = i * G + c; if (L >= 288) return false;
        pg8::static_tile(L, 36, 8, u.pm, u.pn); u.kind = 2; return true;
    }
    __device__ __forceinline__ const char* a_ptr(const pg8::Unit& u) const { return BRANCH + (size_t)u.pm * pg8::TSTEP; }
    __device__ __forceinline__ const char* b_ptr(const pg8::Unit& u) const { return WO + (size_t)u.pn * pg8::TSTEP; }
    __device__ __forceinline__ void epi(const pg8::Acc& acc, const pg8::Unit& u, int wr, int wc, int fr, int fq) const {
        const int row0 = u.pm * 256 + wr * 64 + fr; const int col0 = u.pn * 256 + wc * 32 + 8 * fq;
        const float* xb = (u.pm < 32) ? xp : (xs - (size_t)NP * DM);
#pragma unroll
        for (int ai = 0; ai < 2; ++ai)
#pragma unroll
            for (int m = 0; m < 4; ++m) { const size_t off = (size_t)(row0 + ai * 128 + m * 16) * DM + col0;
#pragma unroll
                for (int bj = 0; bj < 2; ++bj) { const f32x4 x0 = *(const f32x4*)(xb + off + bj * 128), x1 = *(const f32x4*)(xb + off + bj * 128 + 4);
                    *(f32x4*)(out + off + bj * 128) = acc[ai][bj][m][0] + x0; *(f32x4*)(out + off + bj * 128 + 4) = acc[ai][bj][m][1] + x1; } }
    }
};

__device__ __forceinline__ void norm_row_to_bf16(const float* src, const float* w, bf16_t* dst, int lane) {
    const f32x4* s = (const f32x4*)src + lane; const f32x4* wv = (const f32x4*)w + lane;
    f32x4 v[8]; float ss = 0.f;
#pragma unroll
    for (int j = 0; j < 8; ++j) { v[j] = s[64 * j]; ss += (v[j].x * v[j].x + v[j].y * v[j].y) + (v[j].z * v[j].z + v[j].w * v[j].w); }
    const float rstd = 1.0f / sqrtf(wave_sum(ss) * (1.0f / DM) + EPS);
    u32x2* o = (u32x2*)dst + lane;
#pragma unroll
    for (int j = 0; j < 8; ++j) { const f32x4 ww = wv[64 * j]; u32x2 r; r.x = pk2(v[j].x * rstd * ww.x, v[j].y * rstd * ww.y); r.y = pk2(v[j].z * rstd * ww.z, v[j].w * rstd * ww.w); o[64 * j] = r; }
}
__device__ __forceinline__ void transpose_item(const float* W, int ldw, int csrc, bf16_t* WT, int n0, int k0, LAS float* scr, int lane) {
#pragma unroll 8
    for (int i = 0; i < 32; ++i) { const int kk = 2 * i + (lane >> 5); scr[kk * 33 + (lane & 31)] = W[(size_t)(k0 + kk) * ldw + csrc + (lane & 31)]; }
    asm volatile("s_waitcnt lgkmcnt(0)" ::: "memory");
    const int c = lane & 7;
#pragma unroll
    for (int j = 0; j < 4; ++j) { const int n = (lane >> 3) + 8 * j; const LAS float* s = scr + (8 * c) * 33 + n;
        u32x4 o; o.x = pk2(s[0 * 33], s[1 * 33]); o.y = pk2(s[2 * 33], s[3 * 33]); o.z = pk2(s[4 * 33], s[5 * 33]); o.w = pk2(s[6 * 33], s[7 * 33]);
        *(u32x4*)(WT + (size_t)(n0 + n) * DM + k0 + 8 * c) = o; }
    asm volatile("s_waitcnt lgkmcnt(0)" ::: "memory");
}
__device__ __forceinline__ void phase_prep(const Params& p, LAS unsigned char* lds) {
    const int tid = threadIdx.x, lane = tid & 63, wave = tid >> 6;
    const int gw = blockIdx.x * 8 + wave, NGW = gridDim.x * 8;
    unsigned char* ws = p.ws;
    bf16_t* XB = (bf16_t*)(ws + WS_XB); bf16_t* MB = (bf16_t*)(ws + WS_MB);
    for (int r = gw; r < NTOK + NMR; r += NGW) {
        if (r < NP) norm_row_to_bf16(p.x_prompt + (size_t)r * DM, p.norm_w, XB + (size_t)r * DM, lane);
        else if (r < NTOK) norm_row_to_bf16(p.x_sample + (size_t)(r - NP) * DM, p.norm_w, XB + (size_t)r * DM, lane);
        else norm_row_to_bf16(p.mem + (size_t)(r - NTOK) * DM, p.mem_norm_w, MB + (size_t)(r - NTOK) * DM, lane);
    }
    LAS float* scr = (LAS float*)(lds + wave * 8704);
    constexpr int I_IN = 32 * (DINP / 32), I_M = 32 * (1024 / 32), I_O = 32 * (2048 / 32);
    bf16_t* WIN = (bf16_t*)(ws + WS_WIN); bf16_t* WM = (bf16_t*)(ws + WS_WM); bf16_t* WO = (bf16_t*)(ws + WS_WO); bf16_t* WR = (bf16_t*)(ws + WS_WR);
    for (int it = gw; it < I_IN + I_M + I_O; it += NGW) {
        int r = it;
        if (r < I_IN) { const int nb = r % (DINP / 32), kb = r / (DINP / 32), n0 = nb * 32; transpose_item(p.w_in, DIN, n0 + (n0 >= SRC_BR ? 16 : 0), WIN, n0, kb * 64, scr, lane); continue; }
        r -= I_IN;
        if (r < I_M) { const int nb = r % 32, kb = r / 32; transpose_item(p.w_mem, 1024, nb * 32, WM, nb * 32, kb * 64, scr, lane); continue; }
        r -= I_M;
        { const int nb = r % 64, kb = r / 64; transpose_item(p.w_out, 2048, nb * 32, WO, nb * 32, kb * 64, scr, lane); }
    }
    for (int i = blockIdx.x * NTHREADS + tid; i < 16 * DM; i += gridDim.x * NTHREADS) { const int r = i & 15, k = i >> 4; WR[r * DM + k] = (bf16_t)f2bf(p.w_in[(size_t)k * DIN + SRC_BR + r]); }
}

__device__ __forceinline__ void br_task(const bf16_t* XB, const bf16_t* WR, float* BR, int task, int wave, int lane) {
    const int fr = lane & 15, fq = lane >> 4, row0 = task * 128 + wave * 16;
    const bf16_t* ap = XB + (size_t)(row0 + fr) * DM + 8 * fq; const bf16_t* bp = WR + (size_t)fr * DM + 8 * fq;
    f32x4 acc = (f32x4){0.f, 0.f, 0.f, 0.f};
#pragma unroll 8
    for (int k0 = 0; k0 < DM; k0 += 32) { const bf16x8 a = *(const bf16x8*)(ap + k0), b = *(const bf16x8*)(bp + k0); acc = __builtin_amdgcn_mfma_f32_16x16x32_bf16(a, b, acc, 0, 0, 0); }
#pragma unroll
    for (int j = 0; j < 4; ++j) BR[(size_t)(row0 + 4 * fq + j) * 16 + fr] = acc[j];
}

__device__ __forceinline__ void mixA_task(const Params& p, LAS unsigned char* lds, int row0, int h, int L, bool write_cv) {
    int tid_ = threadIdx.x; asm volatile("" : "+v"(tid_)); const int tid = tid_, lane = tid & 63, wave = tid >> 6;
    const bf16_t* PROJ = (const bf16_t*)(p.ws + WS_PROJ); bf16_t* BRANCH = (bf16_t*)(p.ws + WS_BRANCH);
    LAS float* Wl = (LAS float*)lds;
    LAS bf16_t* vn = (LAS bf16_t*)(lds + 65536);
    LAS float* rs = (LAS float*)(lds + 65536 + 49152);
    __syncthreads();
    for (int t = wave * 16; t < wave * 16 + 16; ++t) {
        const u32x2* src = (const u32x2*)(PROJ + (size_t)(row0 + t) * DINP + C_AV) + lane; float ss = 0.f;
#pragma unroll
        for (int j = 0; j < 3; ++j) { const u32x2 w = src[64 * j]; const float a = bflo(w.x), b = bfhi(w.x), c = bflo(w.y), d = bfhi(w.y); ss += (a * a + b * b) + (c * c + d * d); }
        ss = wave_sum(ss);
        if (lane == 0) rs[t] = 1.0f / sqrtf(ss * (1.0f / 768.0f) + EPS);
    }
    for (int i = tid; i < 128 * 32; i += NTHREADS) ((LAS f32x4*)Wl)[i] = ((const f32x4*)(p.a_ws + (size_t)h * 16384))[i];
    __syncthreads();
    for (int i = tid; i < 128 * 192; i += NTHREADS) { const int t = i / 192, dd = i % 192;
        const float v = bf2f(PROJ[(size_t)(row0 + t) * DINP + C_AV + h * 192 + dd]) * rs[t] * p.a_vnorm_w[h * 192 + dd];
        vn[i] = (bf16_t)f2bf(v);
        if (write_cv) p.out[O_CV + (size_t)(row0 - NP + t) * 768 + h * 192 + dd] = v; }
    __syncthreads();
    if (tid < 384) {
        const int dd2 = tid % 96, ig = tid / 96;
        for (int k = 0; k < 32; ++k) {
            const int rl = ig + 4 * k, i = rl % L, cs = rl - i;
            float a0 = 0.f, a1 = 0.f;
            for (int j = 0; j <= i; ++j) { const float w = Wl[i * 128 + j]; const unsigned v = *(const LAS unsigned*)(vn + (cs + j) * 192 + 2 * dd2); a0 += w * bflo(v); a1 += w * bfhi(v); }
            const float bsv = p.a_bs[h * 128 + i]; a0 += bsv; a1 += bsv;
            const size_t rb = (size_t)(row0 + rl) * DINP + h * 192 + 2 * dd2;
            const unsigned uu = *(const unsigned*)(PROJ + rb + C_AU), gg = *(const unsigned*)(PROJ + rb + C_AG);
            const float o0 = bflo(uu) * a0 * silu(bflo(gg)), o1 = bfhi(uu) * a1 * silu(bfhi(gg));
            *(unsigned*)(BRANCH + (size_t)(row0 + rl) * DM + h * 192 + 2 * dd2) = pk2(o0, o1);
        }
    }
}

template <bool F32SRC>
__device__ __forceinline__ void mixX_task(const Params& p, LAS unsigned char* lds, const void* Ksrc, const void* Vsrc, int kvrow0, int h, int qrow0, int nq) {
    int tid_ = threadIdx.x; asm volatile("" : "+v"(tid_)); const int tid = tid_, lane = tid & 63, wave = tid >> 6;
    const bf16_t* PROJ = (const bf16_t*)(p.ws + WS_PROJ); bf16_t* BRANCH = (bf16_t*)(p.ws + WS_BRANCH);
    LAS unsigned char* Kl = lds;
    LAS unsigned char* Vl = lds + 69632;
    LAS float* qs = (LAS float*)(lds + 69632 + 65536) + wave * 128;
    LAS float* ps = (LAS float*)(lds + 69632 + 65536 + 4096) + wave * 256;
    __syncthreads();
    if (F32SRC) {
        const float* K = (const float*)Ksrc; const float* V = (const float*)Vsrc;
        for (int i = tid; i < 256 * 32; i += NTHREADS) { const int n = i >> 5, ch = i & 31; const size_t g = (size_t)(kvrow0 + n) * 512 + h * 128 + ch * 4;
            const f32x4 kv = *(const f32x4*)(K + g), vv = *(const f32x4*)(V + g);
            u32x2 a; a.x = pk2(kv.x, kv.y); a.y = pk2(kv.z, kv.w); *(LAS u32x2*)(Kl + n * 272 + ch * 8) = a;
            u32x2 b; b.x = pk2(vv.x, vv.y); b.y = pk2(vv.z, vv.w); *(LAS u32x2*)(Vl + n * 256 + ch * 8) = b; }
    } else {
        const bf16_t* K = (const bf16_t*)Ksrc; const bf16_t* V = (const bf16_t*)Vsrc;
        for (int i = tid; i < 256 * 16; i += NTHREADS) { const int n = i >> 4, ch = i & 15; const size_t g = (size_t)(kvrow0 + n) * 512 + h * 128 + ch * 8;
            *(LAS u32x4*)(Kl + n * 272 + ch * 16) = *(const u32x4*)(K + g); *(LAS u32x4*)(Vl + n * 256 + ch * 16) = *(const u32x4*)(V + g); }
    }
    __syncthreads();
    for (int qi = wave; qi < nq; qi += 8) {
        const int row = qrow0 + qi;
        { const unsigned w = *(const unsigned*)(PROJ + (size_t)row * DINP + C_XQ + h * 128 + 2 * lane); qs[2 * lane] = bflo(w) * 0.08838834764831845f; qs[2 * lane + 1] = bfhi(w) * 0.08838834764831845f; }
        asm volatile("s_waitcnt lgkmcnt(0)" ::: "memory");
        float s[4] = {0.f, 0.f, 0.f, 0.f};
        for (int c = 0; c < 16; ++c) {
            const f32x4 qa = *(const LAS f32x4*)(qs + 8 * c), qb = *(const LAS f32x4*)(qs + 8 * c + 4);
#pragma unroll
            for (int kk = 0; kk < 4; ++kk) { const u32x4 kv = *(const LAS u32x4*)(Kl + (lane + 64 * kk) * 272 + c * 16);
                s[kk] += (qa.x * bflo(kv.x) + qa.y * bfhi(kv.x)) + (qa.z * bflo(kv.y) + qa.w * bfhi(kv.y)) + (qb.x * bflo(kv.z) + qb.y * bfhi(kv.z)) + (qb.z * bflo(kv.w) + qb.w * bfhi(kv.w)); }
        }
        const float mx = wave_max(fmaxf(fmaxf(s[0], s[1]), fmaxf(s[2], s[3])));
        float e[4], sum = 0.f;
#pragma unroll
        for (int kk = 0; kk < 4; ++kk) { e[kk] = __expf(s[kk] - mx); sum += e[kk]; }
        const float inv = 1.0f / wave_sum(sum);
#pragma unroll
        for (int kk = 0; kk < 4; ++kk) ps[lane + 64 * kk] = e[kk] * inv;
        asm volatile("s_waitcnt lgkmcnt(0)" ::: "memory");
        float o0 = 0.f, o1 = 0.f;
        for (int n = 0; n < 256; n += 4) { const f32x4 pp = *(const LAS f32x4*)(ps + n);
#pragma unroll
            for (int j = 0; j < 4; ++j) { const unsigned v = *(const LAS unsigned*)(Vl + (n + j) * 256 + lane * 4); o0 += pp[j] * bflo(v); o1 += pp[j] * bfhi(v); } }
        const unsigned g = *(const unsigned*)(PROJ + (size_t)row * DINP + C_XG + h * 128 + 2 * lane);
        *(unsigned*)(BRANCH + (size_t)row * DM + 1536 + h * 128 + 2 * lane) = pk2(o0 * silu(bflo(g)), o1 * silu(bfhi(g)));
    }
}


__device__ __forceinline__ void mixA2_task(const Params& p, LAS unsigned char* lds, int row0, int h, int L, bool smp) {
    int tid_ = threadIdx.x; asm volatile("" : "+v"(tid_)); const int tid = tid_, lane = tid & 63, w = __builtin_amdgcn_readfirstlane(tid >> 6), fr = lane & 15, fq = lane >> 4;
    const bf16_t* PROJ = (const bf16_t*)(p.ws + WS_PROJ); bf16_t* BRANCH = (bf16_t*)(p.ws + WS_BRANCH);
    LAS unsigned char* Wl = lds;
    LAS unsigned char* vnl = lds + 34816;
    LAS float* rs = (LAS float*)(lds + 34816 + 53248);
    __syncthreads();
    for (int t = w * 16; t < w * 16 + 16; ++t) {
        const u32x2* src = (const u32x2*)(PROJ + (size_t)(row0 + t) * DINP + C_AV) + lane; float ss = 0.f;
#pragma unroll
        for (int j = 0; j < 3; ++j) { const u32x2 x = src[64 * j]; const float a = bflo(x.x), b = bfhi(x.x), c = bflo(x.y), d = bfhi(x.y); ss += (a * a + b * b) + (c * c + d * d); }
        ss = wave_sum(ss);
        if (lane == 0) rs[t] = 1.0f / sqrtf(ss * (1.0f / 768.0f) + EPS);
    }
#pragma unroll
    for (int k = 0; k < 8; ++k) { const int idx = tid + 512 * k, i = idx >> 5, j4 = (idx & 31) * 4; float v[4];
        if (!smp) { const f32x4 x = *(const f32x4*)(p.a_ws + (size_t)h * 16384 + i * 128 + j4);
#pragma unroll
            for (int q = 0; q < 4; ++q) v[q] = (j4 + q <= i) ? x[q] : 0.f; }
        else {
#pragma unroll
            for (int q = 0; q < 4; ++q) { const int j = j4 + q; v[q] = ((j >> 3) == (i >> 3) && (j & 7) <= (i & 7)) ? p.a_ws[(size_t)h * 16384 + (i & 7) * 128 + (j & 7)] : 0.f; } }
        u32x2 o; o.x = pk2(v[0], v[1]); o.y = pk2(v[2], v[3]); *(LAS u32x2*)(Wl + i * 272 + j4 * 2) = o; }
    __syncthreads();
#pragma unroll
    for (int k = 0; k < 6; ++k) { const int idx = tid + 512 * k, t = idx / 24, ch = idx % 24;
        const u32x4 x = *(const u32x4*)(PROJ + (size_t)(row0 + t) * DINP + C_AV + h * 192 + 8 * ch);
        const f32x4 w0 = *(const f32x4*)(p.a_vnorm_w + h * 192 + 8 * ch), w1 = *(const f32x4*)(p.a_vnorm_w + h * 192 + 8 * ch + 4); const float r = rs[t];
        f32x4 v0, v1; v0[0] = bflo(x.x) * r * w0[0]; v0[1] = bfhi(x.x) * r * w0[1]; v0[2] = bflo(x.y) * r * w0[2]; v0[3] = bfhi(x.y) * r * w0[3];
        v1[0] = bflo(x.z) * r * w1[0]; v1[1] = bfhi(x.z) * r * w1[1]; v1[2] = bflo(x.w) * r * w1[2]; v1[3] = bfhi(x.w) * r * w1[3];
        u32x4 o; o.x = pk2(v0[0], v0[1]); o.y = pk2(v0[2], v0[3]); o.z = pk2(v1[0], v1[1]); o.w = pk2(v1[2], v1[3]);
        *(LAS u32x4*)(vnl + t * 416 + ch * 16) = o;
        if (smp) { float* cv = p.out + O_CV + (size_t)(row0 - NP + t) * 768 + h * 192 + 8 * ch; *(f32x4*)cv = v0; *(f32x4*)(cv + 4) = v1; } }
    __syncthreads();
    {
        const int it = w;
        const int ks_lo = smp ? (it >> 1) : 0, ks_hi = smp ? (it >> 1) : ((16 * it + 15) >> 5);
        f32x4 acc[12];
#pragma unroll
        for (int dt = 0; dt < 12; ++dt) acc[dt] = (f32x4){0.f, 0.f, 0.f, 0.f};
        const unsigned vbase = (unsigned)(size_t)vnl + (unsigned)((4 * fq + (fr >> 2)) * 416 + (4 * (fr & 3)) * 2);
        for (int ks = ks_lo; ks <= ks_hi; ++ks) {
            const u32x2 wlo = *(const LAS u32x2*)(Wl + (16 * it + fr) * 272 + (32 * ks + 4 * fq) * 2), whi = *(const LAS u32x2*)(Wl + (16 * it + fr) * 272 + (32 * ks + 16 + 4 * fq) * 2);
            u32x4 wy; wy.x = wlo.x; wy.y = wlo.y; wy.z = whi.x; wy.w = whi.y; const bf16x8 yf = __builtin_bit_cast(bf16x8, wy);
#pragma unroll
            for (int g = 0; g < 3; ++g) { s16x4 lo[4], hi[4];
#pragma unroll
                for (int q = 0; q < 4; ++q) { const unsigned a = vbase + (unsigned)(32 * ks * 416 + (16 * (4 * g + q)) * 2); lo[q] = tr_read(a); hi[q] = tr_read(a + 16 * 416); }
                TR_WAIT();
#pragma unroll
                for (int q = 0; q < 4; ++q) acc[4 * g + q] = MFMA16(PK8(lo[q], hi[q]), yf, acc[4 * g + q]); }
        }
        const int i = 16 * it + fr; const size_t row = (size_t)(row0 + i); const float bsv = p.a_bs[h * 128 + (i % L)];
#pragma unroll
        for (int dt = 0; dt < 12; ++dt) { const int dd0 = 16 * dt + 4 * fq;
            const u32x2 uu = *(const u32x2*)(PROJ + row * DINP + C_AU + h * 192 + dd0), gg = *(const u32x2*)(PROJ + row * DINP + C_AG + h * 192 + dd0);
            u32x2 o; o.x = pk2(bflo(uu.x) * (acc[dt][0] + bsv) * silu(bflo(gg.x)), bfhi(uu.x) * (acc[dt][1] + bsv) * silu(bfhi(gg.x)));
            o.y = pk2(bflo(uu.y) * (acc[dt][2] + bsv) * silu(bflo(gg.y)), bfhi(uu.y) * (acc[dt][3] + bsv) * silu(bfhi(gg.y)));
            *(u32x2*)(BRANCH + row * DM + h * 192 + dd0) = o; }
    }
}

__device__ __forceinline__ void mixXp_task(const Params& p, LAS unsigned char* lds, int b, int h, int qt) {
    int tid_ = threadIdx.x; asm volatile("" : "+v"(tid_)); const int tid = tid_, lane = tid & 63, w = __builtin_amdgcn_readfirstlane(tid >> 6), fr = lane & 15, fq = lane >> 4;
    const bf16_t* PROJ = (const bf16_t*)(p.ws + WS_PROJ); bf16_t* BRANCH = (bf16_t*)(p.ws + WS_BRANCH);
    const bf16_t* MKB = (const bf16_t*)(p.ws + WS_MKB); const bf16_t* MVB = (const bf16_t*)(p.ws + WS_MVB);
    LAS unsigned char* Kl = lds;
    LAS unsigned char* Vl = lds + 69632;
    __syncthreads();
#pragma unroll
    for (int k = 0; k < 8; ++k) { const int idx = tid + 512 * k, n = idx >> 4, ch = idx & 15; const size_t g = (size_t)(b * 256 + n) * 512 + h * 128 + ch * 8;
        *(LAS u32x4*)(Kl + n * 272 + ch * 16) = *(const u32x4*)(MKB + g); *(LAS u32x4*)(Vl + n * 288 + ch * 16) = *(const u32x4*)(MVB + g); }
    const size_t row = (size_t)(b * SEQ + qt * 128 + 16 * w + fr);
    bf16x8 bQ[4];
#pragma unroll
    for (int ks = 0; ks < 4; ++ks) bQ[ks] = *(const bf16x8*)(PROJ + row * DINP + C_XQ + h * 128 + 32 * ks + 8 * fq);
    __syncthreads();
    f32x4 s[16];
#pragma unroll
    for (int nt = 0; nt < 16; ++nt) { f32x4 a = (f32x4){0.f, 0.f, 0.f, 0.f};
#pragma unroll
        for (int ks = 0; ks < 4; ++ks) a = MFMA16(*(const LAS bf16x8*)(Kl + (16 * nt + fr) * 272 + (32 * ks + 8 * fq) * 2), bQ[ks], a);
        s[nt] = a; }
    float mx = -3.0e38f;
#pragma unroll
    for (int nt = 0; nt < 16; ++nt) mx = fmaxf(mx, fmaxf(fmaxf(s[nt][0], s[nt][1]), fmaxf(s[nt][2], s[nt][3])));
    mx = fmaxf(mx, __shfl_xor(mx, 16)); mx = fmaxf(mx, __shfl_xor(mx, 32));
    float l = 0.f; bf16x8 pP[8];
#pragma unroll
    for (int ks = 0; ks < 8; ++ks) { float e[8];
#pragma unroll
        for (int j = 0; j < 4; ++j) { e[j] = __expf((s[2 * ks][j] - mx) * 0.08838834764831845f); e[4 + j] = __expf((s[2 * ks + 1][j] - mx) * 0.08838834764831845f); }
        u32x4 pw; pw.x = pk2(e[0], e[1]); pw.y = pk2(e[2], e[3]); pw.z = pk2(e[4], e[5]); pw.w = pk2(e[6], e[7]); pP[ks] = __builtin_bit_cast(bf16x8, pw);
        l += ((e[0] + e[1]) + (e[2] + e[3])) + ((e[4] + e[5]) + (e[6] + e[7])); }
    l += __shfl_xor(l, 16); l += __shfl_xor(l, 32);
    const float inv = 1.0f / l;
    const unsigned vbase = (unsigned)(size_t)Vl + (unsigned)((4 * fq + (fr >> 2)) * 288 + (4 * (fr & 3)) * 2);
#pragma unroll
    for (int dt = 0; dt < 8; ++dt) {
        const u32x2 gg = *(const u32x2*)(PROJ + row * DINP + C_XG + h * 128 + 16 * dt + 4 * fq);
        f32x4 o = (f32x4){0.f, 0.f, 0.f, 0.f};
#pragma unroll
        for (int half = 0; half < 2; ++half) { s16x4 lo[4], hi[4];
#pragma unroll
            for (int q = 0; q < 4; ++q) { const unsigned a = vbase + (unsigned)((32 * (4 * half + q)) * 288 + (16 * dt) * 2); lo[q] = tr_read(a); hi[q] = tr_read(a + 16 * 288); }
            TR_WAIT();
#pragma unroll
            for (int q = 0; q < 4; ++q) o = MFMA16(PK8(lo[q], hi[q]), pP[4 * half + q], o); }
        u32x2 ow; ow.x = pk2(o[0] * inv * silu(bflo(gg.x)), o[1] * inv * silu(bfhi(gg.x))); ow.y = pk2(o[2] * inv * silu(bflo(gg.y)), o[3] * inv * silu(bfhi(gg.y)));
        *(u32x2*)(BRANCH + row * DM + 1536 + h * 128 + 16 * dt + 4 * fq) = ow;
    }
}

__device__ __forceinline__ void mixXs_task(const Params& p, LAS unsigned char* lds, int b, int h) {
    int tid_ = threadIdx.x; asm volatile("" : "+v"(tid_)); const int tid = tid_, lane = tid & 63, w = __builtin_amdgcn_readfirstlane(tid >> 6), fr = lane & 15, fq = lane >> 4;
    const bf16_t* PROJ = (const bf16_t*)(p.ws + WS_PROJ); bf16_t* BRANCH = (bf16_t*)(p.ws + WS_BRANCH);
    LAS float* part = (LAS float*)lds;
    LAS float* ml = (LAS float*)(lds + 32768);
    __syncthreads();
    const float* vp = p.cache_v + (size_t)(b * 256 + 32 * w) * 512 + h * 128 + 2 * lane;
    f32x2 vv[32];
#pragma unroll
    for (int kk = 0; kk < 32; ++kk) vv[kk] = *(const f32x2*)(vp + (size_t)kk * 512);
    const size_t qrow = (size_t)(NP + b * 8 + (fr & 7));
    bf16x8 bQ[4];
#pragma unroll
    for (int ks = 0; ks < 4; ++ks) bQ[ks] = *(const bf16x8*)(PROJ + qrow * DINP + C_XQ + h * 128 + 32 * ks + 8 * fq);
    f32x4 s[2];
#pragma unroll
    for (int nt = 0; nt < 2; ++nt) { const float* kp = p.cache_k + (size_t)(b * 256 + 32 * w + 16 * nt + fr) * 512 + h * 128 + 8 * fq; f32x4 a = (f32x4){0.f, 0.f, 0.f, 0.f};
        f32x4 k0[4], k1[4];
#pragma unroll
        for (int ks = 0; ks < 4; ++ks) { k0[ks] = *(const f32x4*)(kp + 32 * ks); k1[ks] = *(const f32x4*)(kp + 32 * ks + 4); }
#pragma unroll
        for (int ks = 0; ks < 4; ++ks) { u32x4 kw; kw.x = pk2(k0[ks][0], k0[ks][1]); kw.y = pk2(k0[ks][2], k0[ks][3]); kw.z = pk2(k1[ks][0], k1[ks][1]); kw.w = pk2(k1[ks][2], k1[ks][3]);
            a = MFMA16(__builtin_bit_cast(bf16x8, kw), bQ[ks], a); }
        s[nt] = a * 0.08838834764831845f; }
    float mx = fmaxf(fmaxf(fmaxf(s[0][0], s[0][1]), fmaxf(s[0][2], s[0][3])), fmaxf(fmaxf(s[1][0], s[1][1]), fmaxf(s[1][2], s[1][3])));
    mx = fmaxf(mx, __shfl_xor(mx, 16)); mx = fmaxf(mx, __shfl_xor(mx, 32));
    float l = 0.f;
#pragma unroll
    for (int nt = 0; nt < 2; ++nt)
#pragma unroll
        for (int j = 0; j < 4; ++j) { s[nt][j] = __expf(s[nt][j] - mx); l += s[nt][j]; }
    l += __shfl_xor(l, 16); l += __shfl_xor(l, 32);
    if (lane < 8) { ml[(w * 8 + lane) * 2] = mx; ml[(w * 8 + lane) * 2 + 1] = l; }
    f32x2 acc[8];
#pragma unroll
    for (int i = 0; i < 8; ++i) acc[i] = (f32x2){0.f, 0.f};
#pragma unroll
    for (int kk = 0; kk < 32; ++kk) { const int nt = kk >> 4, fqs = (kk & 15) >> 2, j = kk & 3;
        const float sv = s[nt][j]; const int svi = __float_as_int(sv);
#pragma unroll
        for (int i = 0; i < 8; ++i) { const float pv = __int_as_float(__builtin_amdgcn_readlane(svi, i + 16 * fqs)); acc[i] += vv[kk] * pv; } }
#pragma unroll
    for (int i = 0; i < 8; ++i) *(LAS f32x2*)(part + (w * 8 + i) * 128 + 2 * lane) = acc[i];
    __syncthreads();
    { const int i = tid >> 6, dd = 2 * (tid & 63); float M = -3.0e38f;
#pragma unroll
      for (int ww = 0; ww < 8; ++ww) M = fmaxf(M, ml[(ww * 8 + i) * 2]);
      float Lq = 0.f, o0 = 0.f, o1 = 0.f;
#pragma unroll
      for (int ww = 0; ww < 8; ++ww) { const float sc = __expf(ml[(ww * 8 + i) * 2] - M); Lq += ml[(ww * 8 + i) * 2 + 1] * sc; const f32x2 pa = *(const LAS f32x2*)(part + (ww * 8 + i) * 128 + dd); o0 += pa.x * sc; o1 += pa.y * sc; }
      const size_t row = (size_t)(NP + b * 8 + i); const unsigned g = *(const unsigned*)(PROJ + row * DINP + C_XG + h * 128 + dd); const float inv = 1.0f / Lq;
      *(unsigned*)(BRANCH + row * DM + 1536 + h * 128 + dd) = pk2(o0 * inv * silu(bflo(g)), o1 * inv * silu(bfhi(g))); }
}

__device__ __forceinline__ void mixB_task(const Params& p, LAS unsigned char* lds, int row0, int T, int h, const float* s0, float* sout) {
    int tid_ = threadIdx.x; asm volatile("" : "+v"(tid_)); const int tid = tid_, lane = tid & 63, wave = tid >> 6;
    const bf16_t* PROJ = (const bf16_t*)(p.ws + WS_PROJ); bf16_t* BRANCH = (bf16_t*)(p.ws + WS_BRANCH); const float* BR = (const float*)(p.ws + WS_BR);
    LAS float* qs = (LAS float*)lds;
    LAS float* ks = qs + 32 * 96;
    LAS float* al = ks + 32 * 96;
    LAS float* vs = al + 32 * 96;
    LAS float* po = vs + 32 * 192;
    const int e = tid % 192, hf = tid / 192, d0 = hf * 48;
    float S[48];
#pragma unroll
    for (int dd = 0; dd < 48; ++dd) S[dd] = (s0 && tid < 384) ? s0[(size_t)(d0 + dd) * 192 + e] : 0.f;
    const int TC = T < 32 ? T : 32;
    for (int t0 = 0; t0 < T; t0 += TC) {
        __syncthreads();
        for (int i = tid; i < TC * 96; i += NTHREADS) { const int t = i / 96, d = i % 96; const size_t row = (size_t)(row0 + t0 + t);
            float z = p.b_ba[h * 96 + d];
#pragma unroll
            for (int r = 0; r < 16; ++r) z += BR[row * 16 + r] * p.b_wa[r * 384 + h * 96 + d];
            const float la = (fminf(z, 0.f) - log1pf(__expf(-fabsf(z)))) * (1.0f / 16.0f);
            al[i] = __expf(la);
            qs[i] = bf2f(PROJ[row * DINP + C_BQ + h * 96 + d]) * 0.10206207261596577f;
            ks[i] = bf2f(PROJ[row * DINP + C_BK + h * 96 + d]); }
        for (int i = tid; i < TC * 192; i += NTHREADS) { const int t = i / 192, ee = i % 192; vs[i] = bf2f(PROJ[(size_t)(row0 + t0 + t) * DINP + C_BV + h * 192 + ee]); }
        __syncthreads();
        if (tid < 384) {
#pragma unroll 1
            for (int t = 0; t < TC; ++t) {
                const float v = vs[t * 192 + e]; float acc = 0.f;
#pragma unroll
                for (int d4 = 0; d4 < 12; ++d4) {
                    const f32x4 a4 = *(const LAS f32x4*)(al + t * 96 + d0 + 4 * d4), k4 = *(const LAS f32x4*)(ks + t * 96 + d0 + 4 * d4), q4 = *(const LAS f32x4*)(qs + t * 96 + d0 + 4 * d4);
#pragma unroll
                    for (int j = 0; j < 4; ++j) { S[4 * d4 + j] = a4[j] * S[4 * d4 + j] + k4[j] * v; acc += q4[j] * S[4 * d4 + j]; }
                    if ((d4 % 3) == 2) asm volatile("" ::: "memory");
                }
                po[(hf * 32 + t) * 192 + e] = acc;
            }
        }
        __syncthreads();
        for (int t = wave; t < TC; t += 8) {
            const size_t row = (size_t)(row0 + t0 + t);
            float o[3], ss = 0.f;
#pragma unroll
            for (int j = 0; j < 3; ++j) { o[j] = po[t * 192 + lane + 64 * j] + po[(32 + t) * 192 + lane + 64 * j]; ss += o[j] * o[j]; }
            const float rstd = 1.0f / sqrtf(wave_sum(ss) * (1.0f / 192.0f) + EPS);
#pragma unroll
            for (int j = 0; j < 3; ++j) { const int ee = lane + 64 * j; const float g = bf2f(PROJ[row * DINP + C_BG + h * 192 + ee]);
                BRANCH[row * DM + 768 + h * 192 + ee] = (bf16_t)f2bf(o[j] * rstd * p.b_onorm_w[ee] * silu(g)); }
        }
    }
    if (tid < 384) {
#pragma unroll
        for (int dd = 0; dd < 48; ++dd) sout[(size_t)(d0 + dd) * 192 + e] = S[dd];
    }
}


__device__ __forceinline__ void glaP_task(const Params& p, LAS unsigned char* lds, int b, int h) {
    int tid_ = threadIdx.x; asm volatile("" : "+v"(tid_)); const int tid = tid_, lane = tid & 63, w = __builtin_amdgcn_readfirstlane(tid >> 6), fr = lane & 15, fq = lane >> 4;
    LAS bf16_t* Qh  = (LAS bf16_t*)lds;
    LAS bf16_t* Kin = (LAS bf16_t*)(lds + 13312);
    LAS bf16_t* KoT = (LAS bf16_t*)(lds + 26624);
    LAS bf16_t* VT  = (LAS bf16_t*)(lds + 40448);
    LAS bf16_t* ST  = (LAS bf16_t*)(lds + 68096);
    LAS bf16_t* laH = (LAS bf16_t*)(lds + 108032);
    LAS bf16_t* laL = (LAS bf16_t*)(lds + 108032 + 13824);
    LAS bf16_t* Pm  = laH;
    LAS float* cl   = (LAS float*)(lds + 135680);
    LAS float* ssq  = (LAS float*)(lds + 136064);
    LAS float* onw  = (LAS float*)(lds + 136576);
    LAS float* bav  = (LAS float*)(lds + 137344);
    LAS float* gex  = (LAS float*)(lds + 143872);
    LAS unsigned char* WF = lds + 137728;
    const bf16_t* PROJ = (const bf16_t*)(p.ws + WS_PROJ); bf16_t* BRANCH = (bf16_t*)(p.ws + WS_BRANCH); const float* BR = (const float*)(p.ws + WS_BR);
    const int row0 = b * SEQ;
    const int it = w & 3, dt0 = 3 * (w >> 2);
    const int dtS0 = 3 * (w & 1), etS0 = 3 * (w >> 1);
    __syncthreads();
    if (tid < 192) { const int dt = tid >> 5, l32 = tid & 31, d = 16 * dt + (l32 & 15), r0 = 8 * (l32 >> 4); unsigned hi[8], lo[8];
#pragma unroll
        for (int jj = 0; jj < 8; ++jj) { const float wv = p.b_wa[(r0 + jj) * 384 + h * 96 + d]; hi[jj] = f2bf(wv); lo[jj] = f2bf(wv - bf2f((bf16_t)hi[jj])); }
        u32x4 a, c; a.x = hi[0] | (hi[1] << 16); a.y = hi[2] | (hi[3] << 16); a.z = hi[4] | (hi[5] << 16); a.w = hi[6] | (hi[7] << 16);
        c.x = lo[0] | (lo[1] << 16); c.y = lo[2] | (lo[3] << 16); c.z = lo[4] | (lo[5] << 16); c.w = lo[6] | (lo[7] << 16);
        *(LAS u32x4*)(WF + tid * 16) = a; *(LAS u32x4*)(WF + 3072 + tid * 16) = c; }
    for (int i = tid; i < 192; i += NTHREADS) onw[i] = p.b_onorm_w[i];
    for (int i = tid; i < 96; i += NTHREADS) bav[i] = p.b_ba[h * 96 + i];
    for (int i = tid; i < 192 * 104 / 2; i += NTHREADS) ((LAS unsigned*)ST)[i] = 0u;
    f32x4 S[3][3];
#pragma unroll
    for (int a = 0; a < 3; ++a)
#pragma unroll
        for (int e = 0; e < 3; ++e) S[a][e] = (f32x4){0.f, 0.f, 0.f, 0.f};
    const bf16_t* qkp = PROJ + (size_t)(row0 + 16 * it + fr) * DINP + C_BQ + h * 96 + 16 * dt0 + 4 * fq;
    const float* brp = BR + (size_t)(row0 + 16 * it + fr) * 16 + 8 * (fq & 1);
    const int gofs = (C_BG - C_BQ) + h * 96 + 96 * (w >> 2) - 16 * dt0;
    const int vjr = tid >> 3, vc0 = tid & 7;
    const bf16_t* vp = PROJ + (size_t)(row0 + vjr) * DINP + C_BV + h * 192 + 8 * vc0;
    u32x2 qv[3], kv[3]; f32x4 brv[2]; u32x4 vv[3];
#define GLA_LOAD_QKV(cc) do { const size_t _o = (size_t)(cc) * 64 * DINP; _Pragma("unroll") for (int n = 0; n < 3; ++n) { qv[n] = *(const u32x2*)(qkp + _o + 16 * n); kv[n] = *(const u32x2*)(qkp + _o + 384 + 16 * n); } \
        _Pragma("unroll") for (int k = 0; k < 3; ++k) vv[k] = *(const u32x4*)(vp + _o + 64 * k); } while (0)
#define GLA_LOAD_BR(cc) do { const size_t _o = (size_t)(cc) * 64 * 16; brv[0] = *(const f32x4*)(brp + _o); brv[1] = *(const f32x4*)(brp + _o + 4); } while (0)
    GLA_LOAD_BR(0); GLA_LOAD_QKV(0);
    __syncthreads();
#pragma unroll 1
    for (int c = 0; c < 32; ++c) {
        const int cn = c < 31 ? c + 1 : 31;
        {
            bf16x8 bfrag;
            const float f[8] = {brv[0].x, brv[0].y, brv[0].z, brv[0].w, brv[1].x, brv[1].y, brv[1].z, brv[1].w};
#pragma unroll
            for (int jj = 0; jj < 8; ++jj) { const unsigned hi = f2bf(f[jj]); bfrag[jj] = (fq < 2) ? (short)hi : (short)f2bf(f[jj] - bf2f((bf16_t)hi)); }
            GLA_LOAD_BR(cn);
#pragma unroll
            for (int n = 0; n < 3; ++n) {
                const int wo = ((dt0 + n) * 32 + (fq & 1) * 16 + fr) * 16;
                const bf16x8 a1 = *(const LAS bf16x8*)(WF + wo); bf16x8 a2 = *(const LAS bf16x8*)(WF + 3072 + wo);
                if (fq >= 2) a2 = (bf16x8){0, 0, 0, 0, 0, 0, 0, 0};
                f32x4 zt = MFMA16(a1, bfrag, ((f32x4){0.f, 0.f, 0.f, 0.f})); zt = MFMA16(a2, bfrag, zt);
                const f32x4 b4 = *(const LAS f32x4*)(bav + 16 * (dt0 + n) + 4 * fq);
#pragma unroll
                for (int j = 0; j < 4; ++j) { const float z = zt[j] + b4[j]; const float la = (fminf(z, 0.f) - __logf(1.0f + __expf(-fabsf(z)))) * 0.0625f;
                    const unsigned hi = f2bf(la), lo = f2bf(la - bf2f((bf16_t)hi)); const int o = (16 * (dt0 + n) + 4 * fq + j) * 72 + 16 * it + fr;
                    laH[o] = (bf16_t)hi; laL[o] = (bf16_t)lo; }
            }
        }
        LBAR();
        f32x4 cu[3];
#pragma unroll
        for (int n = 0; n < 3; ++n) cu[n] = (f32x4){0.f, 0.f, 0.f, 0.f};
#pragma unroll
        for (int ks = 0; ks < 2; ++ks) if (ks == 0 || it >= 2) {
            bf16x8 lt;
#pragma unroll
            for (int jj = 0; jj < 8; ++jj) lt[jj] = ((32 * ks + 8 * fq + jj) <= (16 * it + fr)) ? (short)0x3F80 : (short)0;
#pragma unroll
            for (int n = 0; n < 3; ++n) { const int o = (16 * (dt0 + n) + fr) * 72 + 32 * ks + 8 * fq;
                cu[n] = MFMA16(*(const LAS bf16x8*)(laH + o), lt, cu[n]); cu[n] = MFMA16(*(const LAS bf16x8*)(laL + o), lt, cu[n]); }
        }
        if (it == 3 && fr == 15) {
#pragma unroll
            for (int n = 0; n < 3; ++n) { *(LAS f32x4*)(cl + 16 * (dt0 + n) + 4 * fq) = cu[n]; f32x4 ge; ge[0] = __expf(cu[n][0]); ge[1] = __expf(cu[n][1]); ge[2] = __expf(cu[n][2]); ge[3] = __expf(cu[n][3]);
                *(LAS f32x4*)(gex + 16 * (dt0 + n) + 4 * fq) = ge; }
        }
        LBAR();
        {
            const int i = 16 * it + fr;
#pragma unroll
            for (int n = 0; n < 3; ++n) {
                const int d = 16 * (dt0 + n) + 4 * fq;
                const f32x4 gxv = *(const LAS f32x4*)(gex + d);
                const float qf[4] = {bflo(qv[n].x), bfhi(qv[n].x), bflo(qv[n].y), bfhi(qv[n].y)}, kf[4] = {bflo(kv[n].x), bfhi(kv[n].x), bflo(kv[n].y), bfhi(kv[n].y)};
                float qh[4], ki[4];
#pragma unroll
                for (int j = 0; j < 4; ++j) { const float cc = cu[n][j]; qh[j] = qf[j] * 0.10206207261596577f * __expf(cc); ki[j] = kf[j] * __expf(-cc);
                    KoT[(d + j) * 72 + i] = (bf16_t)f2bf(ki[j] * gxv[j]); }
                u32x2 wq, wk; wq.x = pk2(qh[0], qh[1]); wq.y = pk2(qh[2], qh[3]); wk.x = pk2(ki[0], ki[1]); wk.y = pk2(ki[2], ki[3]);
                *(LAS u32x2*)(Qh + i * 104 + d) = wq; *(LAS u32x2*)(Kin + i * 104 + d) = wk;
            }
#pragma unroll
            for (int k = 0; k < 3; ++k) { const unsigned ww[4] = {vv[k].x, vv[k].y, vv[k].z, vv[k].w}; LAS bf16_t* vt = VT + (8 * (vc0 + 8 * k)) * 72 + vjr;
#pragma unroll
                for (int q = 0; q < 4; ++q) { vt[(2 * q) * 72] = (bf16_t)(ww[q] & 0xffffu); vt[(2 * q + 1) * 72] = (bf16_t)(ww[q] >> 16); } }
            GLA_LOAD_QKV(cn);
        }
        LBAR();
        {
            const int ita = w >> 1;
#pragma unroll
            for (int j2 = 0; j2 < 2; ++j2) { const int jt = 2 * (w & 1) + j2; u32x2 wp; wp.x = 0u; wp.y = 0u;
                if (jt <= ita) { f32x4 pt = (f32x4){0.f, 0.f, 0.f, 0.f};
#pragma unroll
                    for (int ks = 0; ks < 3; ++ks) pt = MFMA16(*(const LAS bf16x8*)(Kin + (16 * jt + fr) * 104 + 32 * ks + 8 * fq), *(const LAS bf16x8*)(Qh + (16 * ita + fr) * 104 + 32 * ks + 8 * fq), pt);
                    if (jt == ita) {
#pragma unroll
                        for (int j = 0; j < 4; ++j) if (4 * fq + j > fr) pt[j] = 0.f; }
                    wp.x = pk2(pt[0], pt[1]); wp.y = pk2(pt[2], pt[3]); }
                *(LAS u32x2*)(Pm + (16 * ita + fr) * 72 + 16 * jt + 4 * fq) = wp; }
        }
        LBAR();
        f32x4 oacc[6]; u32x2 gv[6];
        {
            { const bf16_t* gp = qkp + (size_t)c * 64 * DINP + gofs;
#pragma unroll
              for (int m = 0; m < 6; ++m) gv[m] = *(const u32x2*)(gp + 16 * m); }
            bf16x8 bP0, bP1, bQ[3];
            bP0 = *(const LAS bf16x8*)(Pm + (16 * it + fr) * 72 + 8 * fq); bP1 = *(const LAS bf16x8*)(Pm + (16 * it + fr) * 72 + 32 + 8 * fq);
#pragma unroll
            for (int ks = 0; ks < 3; ++ks) bQ[ks] = *(const LAS bf16x8*)(Qh + (16 * it + fr) * 104 + 32 * ks + 8 * fq);
            const LAS bf16_t* vtb = VT + (96 * (w >> 2) + fr) * 72 + 8 * fq; const LAS bf16_t* stb = ST + (96 * (w >> 2) + fr) * 104 + 8 * fq;
#pragma unroll
            for (int m = 0; m < 6; ++m) {
                f32x4 o = MFMA16(*(const LAS bf16x8*)(vtb + m * 16 * 72), bP0, ((f32x4){0.f, 0.f, 0.f, 0.f}));
                if (it >= 2) o = MFMA16(*(const LAS bf16x8*)(vtb + m * 16 * 72 + 32), bP1, o);
#pragma unroll
                for (int ks = 0; ks < 3; ++ks) o = MFMA16(*(const LAS bf16x8*)(stb + m * 16 * 104 + 32 * ks), bQ[ks], o);
                oacc[m] = o; }
            float ss = 0.f;
#pragma unroll
            for (int m = 0; m < 6; ++m) ss += (oacc[m][0] * oacc[m][0] + oacc[m][1] * oacc[m][1]) + (oacc[m][2] * oacc[m][2] + oacc[m][3] * oacc[m][3]);
            ss += __shfl_xor(ss, 16); ss += __shfl_xor(ss, 32);
            if (fq == 0) ssq[(16 * it + fr) * 2 + (w >> 2)] = ss;
#pragma unroll
            for (int a = 0; a < 3; ++a) { const f32x4 g4 = *(const LAS f32x4*)(gex + 16 * (dtS0 + a) + 4 * fq);
#pragma unroll
                for (int e = 0; e < 3; ++e) S[a][e] = S[a][e] * g4; }
            const LAS bf16_t* kob = KoT + (16 * dtS0 + fr) * 72 + 8 * fq; const LAS bf16_t* vsb = VT + (16 * etS0 + fr) * 72 + 8 * fq;
#pragma unroll
            for (int ks = 0; ks < 2; ++ks) { bf16x8 aK[3], bV[3];
#pragma unroll
                for (int a = 0; a < 3; ++a) aK[a] = *(const LAS bf16x8*)(kob + a * 16 * 72 + 32 * ks);
#pragma unroll
                for (int e = 0; e < 3; ++e) bV[e] = *(const LAS bf16x8*)(vsb + e * 16 * 72 + 32 * ks);
#pragma unroll
                for (int a = 0; a < 3; ++a)
#pragma unroll
                    for (int e = 0; e < 3; ++e) S[a][e] = MFMA16(aK[a], bV[e], S[a][e]); }
        }
        LBAR();
#pragma unroll
        for (int a = 0; a < 3; ++a)
#pragma unroll
            for (int e = 0; e < 3; ++e) { u32x2 ws_; ws_.x = pk2(S[a][e][0], S[a][e][1]); ws_.y = pk2(S[a][e][2], S[a][e][3]); *(LAS u32x2*)(ST + (16 * (etS0 + e) + fr) * 104 + 16 * (dtS0 + a) + 4 * fq) = ws_; }
        {
            const int i = 16 * it + fr; const f32x2 sp = *(const LAS f32x2*)(ssq + 2 * i);
            const float rstd = 1.0f / sqrtf((sp.x + sp.y) * (1.0f / 192.0f) + EPS);
            bf16_t* orow = BRANCH + (size_t)(row0 + 64 * c + i) * DM + 768 + h * 192 + 96 * (w >> 2) + 4 * fq;
#pragma unroll
            for (int m = 0; m < 6; ++m) { const f32x4 ow = *(const LAS f32x4*)(onw + 96 * (w >> 2) + 16 * m + 4 * fq);
                const float g0 = bflo(gv[m].x), g1 = bfhi(gv[m].x), g2 = bflo(gv[m].y), g3 = bfhi(gv[m].y);
                u32x2 wo; wo.x = pk2(oacc[m][0] * rstd * ow[0] * silu(g0), oacc[m][1] * rstd * ow[1] * silu(g1)); wo.y = pk2(oacc[m][2] * rstd * ow[2] * silu(g2), oacc[m][3] * rstd * ow[3] * silu(g3));
                *(u32x2*)(orow + 16 * m) = wo; }
        }
    }
    float* so = p.out + O_SP + (size_t)(b * 4 + h) * 96 * 192;
#pragma unroll
    for (int a = 0; a < 3; ++a)
#pragma unroll
        for (int e = 0; e < 3; ++e)
#pragma unroll
            for (int j = 0; j < 4; ++j) so[(size_t)(16 * (dtS0 + a) + 4 * fq + j) * 192 + 16 * (etS0 + e) + fr] = S[a][e][j];
#undef GLA_LOAD_QKV
#undef GLA_LOAD_BR
}

__device__ __forceinline__ void phase_mix(const Params& p, LAS unsigned char* lds) {
    const int G = gridDim.x, c = blockIdx.x;
    const int NBP = 16, NBS = 512, NA = 256 + 32, NXP = 256, NXS = 512, NTASK = NBP + NBS + NA + NXP + NXS;
    for (int t = c; t < NTASK; t += G) {
        int r = t;
        if (r < NBP + NBS) {
            int row0, T, h; const float* s0; float* so;
            if (r < NBP) { glaP_task(p, lds, r >> 2, r & 3);
                continue; }
            { const int q = r - NBP, b = q >> 2; h = q & 3; row0 = NP + b * 8; T = 8; s0 = p.state + (size_t)(b * 4 + h) * 96 * 192; so = p.out + O_SS + (size_t)(b * 4 + h) * 96 * 192; }
            mixB_task(p, lds, row0, T, h, s0, so); continue; }
        r -= NBP + NBS;
        if (r < NA) { const int h = r & 3, blk = r >> 2; const bool smp = r >= 256;
#if USE_A2
            mixA2_task(p, lds, smp ? NP + (blk - 64) * 128 : blk * 128, h, smp ? 8 : 128, smp);
#else
            mixA_task(p, lds, smp ? NP + (blk - 64) * 128 : blk * 128, h, smp ? 8 : 128, smp);
#endif
            continue; }
        r -= NA;
        if (r < NXP) { const int qt = r & 15, h = (r >> 4) & 3, b = r >> 6;
#if USE_XP
            mixXp_task(p, lds, b, h, qt);
#else
            mixX_task<false>(p, lds, p.ws + WS_MKB, p.ws + WS_MVB, b * 256, h, b * SEQ + qt * 128, 128);
#endif
            continue; }
        r -= NXP;
        { const int h = r & 3, b = r >> 2;
#if USE_XS
            mixXs_task(p, lds, b, h);
#else
            mixX_task<true>(p, lds, p.cache_k, p.cache_v, b * 256, h, NP + b * 8, 8);
#endif
        }
    }
}

__device__ __forceinline__ void phase_final(const Params& p) {
    const int lane = threadIdx.x & 63, wave = threadIdx.x >> 6;
    const int gw = blockIdx.x * 8 + wave, NGW = gridDim.x * 8;
    for (int r = gw; r < NTOK; r += NGW) {
        f32x4* s = (f32x4*)(p.out + (size_t)r * DM) + lane; const f32x4* wv = (const f32x4*)p.final_w + lane;
        f32x4 v[8]; float ss = 0.f;
#pragma unroll
        for (int j = 0; j < 8; ++j) { v[j] = s[64 * j]; ss += (v[j].x * v[j].x + v[j].y * v[j].y) + (v[j].z * v[j].z + v[j].w * v[j].w); }
        const float rstd = 1.0f / sqrtf(wave_sum(ss) * (1.0f / DM) + EPS);
#pragma unroll
        for (int j = 0; j < 8; ++j) { const f32x4 ww = wv[64 * j]; s[64 * j] = v[j] * rstd * ww; }
    }
}


#define XB_TMO      128
#define XB_XCNT(j)  (256  + 64 * (j))
#define XB_XSUB(j)  (1280 + 64 * (j))
#define XB_XGEN(j)  (2304 + 64 * (j))
#define XB_TOP      3328
#define XB_TOPGEN   3392
#define XCD_BAR_WORDS 3456
#define XB_SPIN_CAP (1u << 18)
__device__ __forceinline__ unsigned xb_ld(unsigned* p)              { return __hip_atomic_load(p, __ATOMIC_RELAXED, __HIP_MEMORY_SCOPE_AGENT); }
__device__ __forceinline__ unsigned xb_add(unsigned* p, unsigned v) { return __hip_atomic_fetch_add(p, v, __ATOMIC_RELAXED, __HIP_MEMORY_SCOPE_AGENT); }
__device__ __forceinline__ unsigned xb_xcc_id() { return (unsigned)__builtin_amdgcn_s_getreg((3 << 11) | 20) & 0xFu; }
#define XB_SPIN(cond, bar) do { unsigned _sp = 0; while (cond) { __builtin_amdgcn_s_sleep(1); \
    if ((++_sp & 255u) == 0u) { if (xb_ld(&(bar)[XB_TMO])) break; if (_sp > XB_SPIN_CAP) { atomicAdd(&(bar)[XB_TMO], 1u); break; } } } } while (0)
struct XcdBarrier { unsigned* bar; unsigned x; volatile LAS unsigned* st; };
__device__ __forceinline__ XcdBarrier xcd_barrier_post(unsigned* bar, volatile LAS unsigned* st) {
    XcdBarrier b; b.bar = bar; b.x = xb_xcc_id(); b.st = st;
    if (threadIdx.x == 0) (void)xb_add(&bar[XB_XCNT(b.x)], 1u);
    return b;
}
__device__ __forceinline__ void xcd_barrier_complete(unsigned* bar, unsigned x, unsigned& nloc, unsigned& nx) {
    const unsigned G = gridDim.x * gridDim.y * gridDim.z;
    unsigned sum, cnt, mine, sp = 0u;
    for (;;) {
        sum = 0u; cnt = 0u; mine = 0u;
#pragma unroll
        for (unsigned j = 0; j < 16; ++j) { const unsigned c = xb_ld(&bar[XB_XCNT(j)]); sum += c; cnt += (c > 0u) ? 1u : 0u; mine = (j == x) ? c : mine; }
        if (sum == G) break;
        __builtin_amdgcn_s_sleep(1);
        if ((++sp & 255u) == 0u) { if (xb_ld(&bar[XB_TMO])) break; if (sp > XB_SPIN_CAP) { atomicAdd(&bar[XB_TMO], 1u); break; } }
    }
    nloc = mine > 0u ? mine : 1u; nx = cnt > 0u ? cnt : 1u;
}
__device__ __forceinline__ void xcd_barrier(const XcdBarrier& b) {
    asm volatile("s_waitcnt vmcnt(0)" ::: "memory");
    __syncthreads();
    if (threadIdx.x == 0) {
        unsigned* bar = b.bar;
        __builtin_amdgcn_s_waitcnt(0);
        unsigned nloc = b.st[0], nx = b.st[1];
        if (nloc == 0u) { xcd_barrier_complete(bar, b.x, nloc, nx); b.st[0] = nloc; b.st[1] = nx; }
        const unsigned old = xb_add(&bar[XB_XSUB(b.x)], 1u);
        const unsigned gen = old / nloc;
        if (old + 1u == (gen + 1u) * nloc) {
            __builtin_amdgcn_fence(__ATOMIC_RELEASE, "agent");
            asm volatile("s_waitcnt vmcnt(0)" ::: "memory");
            const unsigned og = xb_add(&bar[XB_TOP], 1u);
            const unsigned tg = og / nx;
            if (og + 1u == (tg + 1u) * nx) xb_add(&bar[XB_TOPGEN], 1u);
            else XB_SPIN(xb_ld(&bar[XB_TOPGEN]) == tg, bar);
            __builtin_amdgcn_fence(__ATOMIC_ACQUIRE, "agent");
            xb_add(&bar[XB_XGEN(b.x)], 1u);
            asm volatile("s_waitcnt vmcnt(0)" ::: "memory");
        } else {
            XB_SPIN(xb_ld(&bar[XB_XGEN(b.x)]) == gen, bar);
            __builtin_amdgcn_fence(__ATOMIC_ACQUIRE, "agent");
            asm volatile("s_waitcnt vmcnt(0)" ::: "memory");
        }
    }
    __syncthreads();
}

__global__ void __launch_bounds__(NTHREADS, 2) fwd(Params p) {
    extern __shared__ __attribute__((aligned(16))) unsigned char lds_raw[];
    LAS unsigned char* lds = (LAS unsigned char*)lds_raw;
    const int lo = p.ph_lo, hi = p.ph_hi;
    volatile LAS unsigned* MISC = (volatile LAS unsigned*)(lds + LDS_MISC);
    if (threadIdx.x < 64) MISC[threadIdx.x] = 0u;
    __syncthreads();
    XcdBarrier bar; bar.bar = (unsigned*)(p.ws + WS_CTL) + 4096; bar.x = 0; bar.st = nullptr;
    if (hi - lo > 1) bar = xcd_barrier_post((unsigned*)(p.ws + WS_CTL) + 4096, MISC + 8);
#define BOTH(k) (IN(k) && IN((k) + 1))
#ifndef PH_MASK
#define PH_MASK 31
#endif
#define IN(k) (((PH_MASK >> (k)) & 1) && lo <= (k) && (k) < hi)
    if (IN(0)) { phase_prep(p, lds); if (BOTH(0)) xcd_barrier(bar); }
    if (IN(1)) {
        Prog1 P; P.XB = (const char*)(p.ws + WS_XB); P.WIN = (const char*)(p.ws + WS_WIN); P.MB = (const char*)(p.ws + WS_MB); P.WM = (const char*)(p.ws + WS_WM);
        P.PROJ = (bf16_t*)(p.ws + WS_PROJ); P.out = p.out; P.MKB = (bf16_t*)(p.ws + WS_MKB); P.MVB = (bf16_t*)(p.ws + WS_MVB); P.G = gridDim.x; P.c = blockIdx.x;
        pg8::gemm_phase(lds, P);
        const int wave = threadIdx.x >> 6, lane = threadIdx.x & 63;
        for (int t = (blockIdx.x + gridDim.x - 40) % gridDim.x; t < 72; t += gridDim.x) br_task((const bf16_t*)(p.ws + WS_XB), (const bf16_t*)(p.ws + WS_WR), (float*)(p.ws + WS_BR), t, wave, lane);
        if (BOTH(1)) xcd_barrier(bar);
    }
    if (IN(2)) { phase_mix(p, lds);
#ifdef PROBE_REP2
        phase_mix(p, lds);
#endif
        if (BOTH(2)) xcd_barrier(bar); }
    if (IN(3)) {
        Prog3 P; P.BRANCH = (const char*)(p.ws + WS_BRANCH); P.WO = (const char*)(p.ws + WS_WO); P.xp = p.x_prompt; P.xs = p.x_sample; P.out = p.out; P.G = gridDim.x; P.c = blockIdx.x;
        pg8::gemm_phase(lds, P);
        if (BOTH(3)) xcd_barrier(bar);
    }
    if (IN(4)) phase_final(p);
#undef IN
#undef BOTH
}

extern "C" void kernel_launch(void* const* d_in, const int* in_sizes, int n_in, void* d_out, int out_size, void* d_ws, size_t ws_size, hipStream_t stream) {
    static int grid = 0;
    if (grid == 0) {
        if (n_in != 18 || ws_size < WS_END) { fprintf(stderr, "kernel_launch: unexpected n_in %d or ws_size %zu\n", n_in, ws_size); grid = -1; return; }
        int dev = 0, cus = 0;
        if (hipGetDevice(&dev) != hipSuccess || hipDeviceGetAttribute(&cus, hipDeviceAttributeMultiprocessorCount, dev) != hipSuccess) { grid = -1; return; }
        if (hipFuncSetAttribute((const void*)fwd, hipFuncAttributeMaxDynamicSharedMemorySize, LDS_BYTES) != hipSuccess) { fprintf(stderr, "kernel_launch: hipFuncSetAttribute failed\n"); grid = -1; return; }
        grid = cus > 0 ? cus : 256;
    }
    if (grid < 0) return;
    Params p{};
    const float** pp = (const float**)&p;
    for (int i = 0; i < 18; ++i) pp[i] = (const float*)d_in[i];
    p.out = (float*)d_out; p.ws = (unsigned char*)d_ws;
    (void)hipMemsetAsync((char*)d_ws + WS_CTL, 0, 65536, stream);
#if N_LAUNCH_MODE == 1
    p.ph_lo = 0; p.ph_hi = 5; hipLaunchKernelGGL(fwd, dim3(grid), dim3(NTHREADS), LDS_BYTES, stream, p);
#else
    for (int ph = 0; ph < 5; ++ph) { p.ph_lo = ph; p.ph_hi = ph + 1; hipLaunchKernelGGL(fwd, dim3(grid), dim3(NTHREADS), LDS_BYTES, stream, p); }
#endif
}
```

```cpp
#include <hip/hip_runtime.h>
#include <cstdio>
#include <cstdint>

#define LAS __attribute__((address_space(3)))
typedef unsigned short bf16_t;
typedef short bf16x8 __attribute__((ext_vector_type(8)));
typedef float f32x4 __attribute__((ext_vector_type(4)));
typedef float f32x2 __attribute__((ext_vector_type(2)));
typedef unsigned u32x4 __attribute__((ext_vector_type(4)));
typedef unsigned u32x2 __attribute__((ext_vector_type(2)));

#define USE_A2 1
#define USE_XP 1
#define USE_XS 1
#ifndef N_LAUNCH_MODE
#define N_LAUNCH_MODE 1
#endif

constexpr int DM = 2048;
constexpr int NP = 8192, NS = 1024, NTOK = NP + NS, NMR = 1024;
constexpr int SEQ = 2048, DSEQ = 8, NB = 4, DB = 128, NMEM = 256;
constexpr int DIN = 5648, DINP = 5632;
constexpr int C_AU = 0, C_AV = 768, C_AG = 1536, C_BQ = 2304, C_BK = 2688, C_BV = 3072, C_BG = 3840, C_XQ = 4608, C_XG = 5120;
constexpr int SRC_BR = 3840;
constexpr float EPS = 1e-6f;
constexpr size_t O_Y = 0, O_MK = 18874368, O_MV = 19398656, O_SP = 19922944, O_SS = 20217856, O_CV = 29655040;
constexpr size_t MiB = 1u << 20;
constexpr size_t WS_CTL = 0, CTL_BYTES = 1 * MiB;
constexpr size_t WS_XB = 2 * MiB, WS_MB = 38 * MiB, WS_WIN = 42 * MiB, WS_WM = 64 * MiB, WS_WO = 68 * MiB, WS_WR = 76 * MiB, WS_BR = 77 * MiB,
                 WS_MKB = 78 * MiB, WS_MVB = 79 * MiB, WS_PROJ = 80 * MiB, WS_BRANCH = 180 * MiB, WS_END = 216 * MiB;
constexpr size_t WS_QH = 2 * MiB, WS_KO = 9 * MiB, WS_VT = 16 * MiB, WS_OI = 29 * MiB, WS_GF = 42 * MiB, WS_GX = 55 * MiB;
constexpr int LDS_MISC = 147456;
constexpr int LDS_BYTES = 148480;
constexpr int NTHREADS = 512;

struct Params {
    const float *x_prompt, *x_sample, *mem, *state, *cache_k, *cache_v, *norm_w, *w_in, *a_vnorm_w, *a_ws, *a_bs, *b_wa, *b_ba, *b_onorm_w,
                *mem_norm_w, *w_mem, *w_out, *final_w;
    float* out; unsigned char* ws;
    int ph_lo, ph_hi;
};

typedef __bf16 bf16x2_t __attribute__((ext_vector_type(2)));
__device__ __forceinline__ unsigned cvt_pk_bf16(float lo, float hi) { const f32x2 v = {lo, hi}; const bf16x2_t b = __builtin_convertvector(v, bf16x2_t); return __builtin_bit_cast(unsigned, b); }
__device__ __forceinline__ unsigned pk2(float lo, float hi) { return cvt_pk_bf16(lo, hi); }
__device__ __forceinline__ unsigned f2bf(float f) { return cvt_pk_bf16(f, 0.f) & 0xffffu; }
__device__ __forceinline__ float bflo(unsigned w) { return __builtin_bit_cast(float, w << 16); }
__device__ __forceinline__ float bfhi(unsigned w) { return __builtin_bit_cast(float, w & 0xffff0000u); }
__device__ __forceinline__ float bf2f(bf16_t b) { return __builtin_bit_cast(float, ((unsigned)b) << 16); }
__device__ __forceinline__ float wave_sum(float v) {
#pragma unroll
    for (int o = 1; o < 64; o <<= 1) v += __shfl_xor(v, o);
    return v;
}
__device__ __forceinline__ float wave_max(float v) {
#pragma unroll
    for (int o = 1; o < 64; o <<= 1) v = fmaxf(v, __shfl_xor(v, o));
    return v;
}
__device__ __forceinline__ float silu(float x) { return x * __builtin_amdgcn_rcpf(1.0f + __expf(-x)); }


typedef short s16x4 __attribute__((ext_vector_type(4)));
__device__ __forceinline__ s16x4 tr_read(unsigned addr) { s16x4 r; asm volatile("ds_read_b64_tr_b16 %0, %1" : "=&v"(r) : "v"(addr) : "memory"); return r; }
#define TR_WAIT() do { asm volatile("s_waitcnt lgkmcnt(0)" ::: "memory"); __builtin_amdgcn_sched_barrier(0); } while (0)
#define PK8(L, H) ((bf16x8){(L)[0], (L)[1], (L)[2], (L)[3], (H)[0], (H)[1], (H)[2], (H)[3]})
#define LBAR() do { asm volatile("s_waitcnt lgkmcnt(0)" ::: "memory"); __builtin_amdgcn_s_barrier(); asm volatile("" ::: "memory"); } while (0)
#define MFMA16(a, b, c) __builtin_amdgcn_mfma_f32_16x16x32_bf16((a), (b), (c), 0, 0, 0)

namespace pg8 {
constexpr int BM = 256, BK = 64, HALF = 128, HTB = HALF * BK * 2, STAGE_BYTES = 8 * HTB, NXCD = 8, WGM = 8;
constexpr int K = DM, NT = K / BK;
constexpr size_t TSTEP = (size_t)BM * K * 2;
__device__ __forceinline__ int lds_byte(int r, int c) { const int st = (r >> 4) * 2 + (c >> 5), rr = r & 15, cc = c & 31, ob = rr * 64 + cc * 2; return st * 1024 + (ob ^ (((ob >> 9) & 1) << 5)); }
__device__ __forceinline__ void stage_rc(int b, int& R, int& C) { const int st = b / 1024, sb = b % 1024, swz = sb ^ (((sb >> 9) & 1) << 5); R = (st >> 1) * 16 + swz / 64; C = (st & 1) * 32 + (swz % 64) / 2; }
__device__ __forceinline__ int perm32(int rho) { const int n = rho >> 4, i = rho & 15; return 8 * (i >> 2) + 4 * n + (i & 3); }
struct Unit { int pm, pn, kind; };
__device__ __forceinline__ void static_tile(int L, int nM, int nN, int& pm, int& pn) {
    const int nwg = nM * nN; int wgid = L; { const int q = nwg / NXCD, r = nwg % NXCD, xcd = wgid % NXCD, off = wgid / NXCD; wgid = (xcd < r ? xcd * (q + 1) : r * (q + 1) + (xcd - r) * q) + off; }
    const int nig = WGM * nN, gid = wgid / nig, fm = gid * WGM, gsz = (nM - fm) < WGM ? (nM - fm) : WGM;
    pm = fm + ((wgid % nig) % gsz); pn = (wgid % nig) / gsz;
}
typedef f32x4 Acc[2][2][4][2];

template <class Prog>
__device__ __forceinline__ void gemm_phase(LAS unsigned char* lds, const Prog& P) {
    const int tid = threadIdx.x, wid = __builtin_amdgcn_readfirstlane(tid >> 6), lane = tid & 63, wr = wid >> 2, wc = wid & 3, fr = lane & 15, fq = lane >> 4;
    unsigned voffA[2], voffB[2];
#pragma unroll
    for (int i = 0; i < 2; ++i) { int R, C; stage_rc(tid * 16 + i * 8192, R, C); const int Rb = (R & ~31) + perm32(R & 31);
        voffA[i] = (unsigned)(R * K + C) * 2u; voffB[i] = (unsigned)(Rb * K + C) * 2u; }
    const size_t kstep = (size_t)(BK * 2);
    const size_t hstep = (size_t)HALF * K * 2;
    const unsigned ldsw = (unsigned)wid * 1024u;
    const int aoff = lds_byte(wr * 64 + fr, fq * 8), boff = lds_byte(wc * 32 + fr, fq * 8);
#define PG8_SA(b, h) (((b) * 2 + (h)) * HTB)
#define PG8_SB(b, h) ((4 + (b) * 2 + (h)) * HTB)
#define PG8_STAGE(bufoff, gbase, voff) do { _Pragma("unroll") for (int _i = 0; _i < 2; ++_i) \
        __builtin_amdgcn_global_load_lds((const unsigned*)((const char*)(gbase) + (voff)[_i]), (LAS unsigned*)(lds + (bufoff) + ldsw + _i * 8192), 16, 0, 0); } while (0)
#define PG8_LDA(dst, b, h) do { _Pragma("unroll") for (int m = 0; m < 4; ++m) _Pragma("unroll") for (int k = 0; k < 2; ++k) dst[m][k] = *(const LAS bf16x8*)(lds + PG8_SA(b, h) + aoff + m * 2048 + k * 1024); } while (0)
#define PG8_LDB(dst, b, h) do { _Pragma("unroll") for (int n = 0; n < 2; ++n) _Pragma("unroll") for (int k = 0; k < 2; ++k) dst[n][k] = *(const LAS bf16x8*)(lds + PG8_SB(b, h) + boff + n * 2048 + k * 1024); } while (0)
#define PG8_MMA(ai, bj, At, Bt) do { __builtin_amdgcn_s_setprio(1); _Pragma("unroll") for (int m = 0; m < 4; ++m) _Pragma("unroll") for (int n = 0; n < 2; ++n) _Pragma("unroll") for (int k = 0; k < 2; ++k) \
        acc[ai][bj][m][n] = __builtin_amdgcn_mfma_f32_16x16x32_bf16(Bt[n][k], At[m][k], acc[ai][bj][m][n], 0, 0, 0); __builtin_amdgcn_s_setprio(0); } while (0)
#define PG8_WAIT_V(n) asm volatile("s_waitcnt vmcnt(" #n ")" ::: "memory")
#define PG8_WAIT_L(n) asm volatile("s_waitcnt lgkmcnt(" #n ")" ::: "memory")
#define PG8_BAR __builtin_amdgcn_s_barrier()
#define PG8_SCHED __builtin_amdgcn_sched_barrier(0)
    Unit cur, nxt; int ui = 0;
    if (!P.next(0, cur)) return;
    Acc acc;
#pragma unroll
    for (int a = 0; a < 2; ++a)
#pragma unroll
        for (int b = 0; b < 2; ++b)
#pragma unroll
            for (int m = 0; m < 4; ++m)
#pragma unroll
                for (int n = 0; n < 2; ++n) acc[a][b][m][n] = (f32x4){0.f, 0.f, 0.f, 0.f};
    bf16x8 At[4][2], B0[2][2], B1[2][2];
    const char* cA = P.a_ptr(cur); const char* cB = P.b_ptr(cur);
    PG8_STAGE(PG8_SB(0, 0), cB, voffB); PG8_STAGE(PG8_SA(0, 0), cA, voffA); PG8_STAGE(PG8_SB(0, 1), cB + hstep, voffB); PG8_STAGE(PG8_SA(0, 1), cA + hstep, voffA);
    if (wr == 1) PG8_BAR;
    PG8_WAIT_V(4); PG8_BAR;
    PG8_STAGE(PG8_SB(1, 0), cB + kstep, voffB); PG8_STAGE(PG8_SA(1, 0), cA + kstep, voffA); PG8_STAGE(PG8_SB(1, 1), cB + hstep + kstep, voffB);
    PG8_WAIT_V(6); PG8_BAR;
    for (;;) {
        const bool has_next = P.next(ui + 1, nxt);
        const char* nA = has_next ? P.a_ptr(nxt) : cA; const char* nB = has_next ? P.b_ptr(nxt) : cB;
        for (int t = 0; t < NT; t += 2) {
            const bool last = (t == NT - 2);
            const char* a1 = cA + (size_t)(t + 1) * kstep;
            const char* a2 = last ? nA : cA + (size_t)(t + 2) * kstep; const char* b2 = last ? nB : cB + (size_t)(t + 2) * kstep;
            const char* a3 = a2 + kstep; const char* b3 = b2 + kstep;
            PG8_LDB(B0, 0, 0); PG8_SCHED; PG8_LDA(At, 0, 0); PG8_STAGE(PG8_SA(1, 1), a1 + hstep, voffA);
            PG8_WAIT_L(8); PG8_BAR; PG8_WAIT_L(0); PG8_MMA(0, 0, At, B0); PG8_BAR; PG8_SCHED;
            PG8_LDB(B1, 0, 1); PG8_STAGE(PG8_SB(0, 0), b2, voffB);
            PG8_BAR; PG8_WAIT_L(0); PG8_MMA(0, 1, At, B1); PG8_BAR;
            PG8_LDA(At, 0, 1); PG8_STAGE(PG8_SA(0, 0), a2, voffA);
            PG8_BAR; PG8_WAIT_L(0); PG8_MMA(1, 0, At, B0); PG8_BAR; PG8_SCHED;
            PG8_STAGE(PG8_SB(0, 1), b2 + hstep, voffB);
            PG8_WAIT_V(6); PG8_BAR; PG8_MMA(1, 1, At, B1); PG8_BAR;
            PG8_LDB(B0, 1, 0); PG8_SCHED; PG8_LDA(At, 1, 0); PG8_STAGE(PG8_SA(0, 1), a2 + hstep, voffA);
            PG8_WAIT_L(8); PG8_BAR; PG8_WAIT_L(0); PG8_MMA(0, 0, At, B0); PG8_BAR; PG8_SCHED;
            PG8_LDB(B1, 1, 1); PG8_STAGE(PG8_SB(1, 0), b3, voffB);
            PG8_BAR; PG8_WAIT_L(0); PG8_MMA(0, 1, At, B1); PG8_BAR;
            PG8_LDA(At, 1, 1); PG8_STAGE(PG8_SA(1, 0), a3, voffA);
            PG8_BAR; PG8_WAIT_L(0); PG8_MMA(1, 0, At, B0); PG8_BAR; PG8_SCHED;
            PG8_STAGE(PG8_SB(1, 1), b3 + hstep, voffB);
            PG8_WAIT_V(6); PG8_BAR; PG8_MMA(1, 1, At, B1); PG8_BAR;
        }
        P.epi(acc, cur, wr, wc, fr, fq);
        if (!has_next) break;
#pragma unroll
        for (int a = 0; a < 2; ++a)
#pragma unroll
            for (int b = 0; b < 2; ++b)
#pragma unroll
                for (int m = 0; m < 4; ++m)
#pragma unroll
                    for (int n = 0; n < 2; ++n) acc[a][b][m][n] = (f32x4){0.f, 0.f, 0.f, 0.f};
        cur = nxt; cA = nA; cB = nB; ++ui;
    }
    PG8_WAIT_V(0);
    if (wr == 0) PG8_BAR;
    PG8_BAR;
#undef PG8_SA
#undef PG8_SB
#undef PG8_STAGE
#undef PG8_LDA
#undef PG8_LDB
#undef PG8_MMA
#undef PG8_WAIT_V
#undef PG8_WAIT_L
#undef PG8_BAR
#undef PG8_SCHED
}
}

struct Prog1 {
    const char *XB, *WIN, *MB, *WM; bf16_t* PROJ; float* out; bf16_t *MKB, *MVB; int G, c;
    __device__ __forceinline__ bool next(int i, pg8::Unit& u) const {
        const int L = i * G + c; if (L >= 808) return false;
        if (L < 792) { pg8::static_tile(L, 36, 22, u.pm, u.pn); u.kind = 0; } else { const int r = L - 792; u.pm = r >> 2; u.pn = r & 3; u.kind = 1; }
        return true;
    }
    __device__ __forceinline__ const char* a_ptr(const pg8::Unit& u) const { return (u.kind == 0 ? XB : MB) + (size_t)u.pm * pg8::TSTEP; }
    __device__ __forceinline__ const char* b_ptr(const pg8::Unit& u) const { return (u.kind == 0 ? WIN : WM) + (size_t)u.pn * pg8::TSTEP; }
    __device__ __forceinline__ void epi(const pg8::Acc& acc, const pg8::Unit& u, int wr, int wc, int fr, int fq) const {
        const int row0 = u.pm * 256 + wr * 64 + fr;
        if (u.kind == 0) {
            const int col0 = u.pn * 256 + wc * 32 + 8 * fq;
#pragma unroll
            for (int ai = 0; ai < 2; ++ai)
#pragma unroll
                for (int m = 0; m < 4; ++m) { bf16_t* rowp = PROJ + (size_t)(row0 + ai * 128 + m * 16) * DINP + col0;
#pragma unroll
                    for (int bj = 0; bj < 2; ++bj) { const f32x4 v0 = acc[ai][bj][m][0], v1 = acc[ai][bj][m][1];
                        u32x4 w; w.x = cvt_pk_bf16(v0[0], v0[1]); w.y = cvt_pk_bf16(v0[2], v0[3]); w.z = cvt_pk_bf16(v1[0], v1[1]); w.w = cvt_pk_bf16(v1[2], v1[3]);
                        *(u32x4*)(rowp + bj * 128) = w; } }
        } else {
            const int col0 = (u.pn & 1) * 256 + wc * 32 + 8 * fq;
            float* dst = out + (u.pn < 2 ? O_MK : O_MV); bf16_t* dstb = (u.pn < 2 ? MKB : MVB);
#pragma unroll
            for (int ai = 0; ai < 2; ++ai)
#pragma unroll
                for (int m = 0; m < 4; ++m) { const size_t off = (size_t)(row0 + ai * 128 + m * 16) * 512 + col0;
#pragma unroll
                    for (int bj = 0; bj < 2; ++bj) { const f32x4 v0 = acc[ai][bj][m][0], v1 = acc[ai][bj][m][1];
                        *(f32x4*)(dst + off + bj * 128) = v0; *(f32x4*)(dst + off + bj * 128 + 4) = v1;
                        u32x4 w; w.x = cvt_pk_bf16(v0[0], v0[1]); w.y = cvt_pk_bf16(v0[2], v0[3]); w.z = cvt_pk_bf16(v1[0], v1[1]); w.w = cvt_pk_bf16(v1[2], v1[3]);
                        *(u32x4*)(dstb + off + bj * 128) = w; } }
        }
    }
};
struct Prog3 {
    const char *BRANCH, *WO; const float *xp, *xs; float* out; int G, c;
    __device__ __forceinline__ bool next(int i, pg8::Unit& u) const {
        const int L = i * G + c; if (L >= 288) return false;
        pg8::static_tile(L, 36, 8, u.pm, u.pn); u.kind = 2; return true;
    }
    __device__ __forceinline__ const char* a_ptr(const pg8::Unit& u) const { return BRANCH + (size_t)u.pm * pg8::TSTEP; }
    __device__ __forceinline__ const char* b_ptr(const pg8::Unit& u) const { return WO + (size_t)u.pn * pg8::TSTEP; }
    __device__ __forceinline__ void epi(const pg8::Acc& acc, const pg8::Unit& u, int wr, int wc, int fr, int fq) const {
        const int row0 = u.pm * 256 + wr * 64 + fr; const int col0 = u.pn * 256 + wc * 32 + 8 * fq;
        const float* xb = (u.pm < 32) ? xp : (xs - (size_t)NP * DM);
#pragma unroll
        for (int ai = 0; ai < 2; ++ai)
#pragma unroll
            for (int m = 0; m < 4; ++m) { const size_t off = (size_t)(row0 + ai * 128 + m * 16) * DM + col0;
#pragma unroll
                for (int bj = 0; bj < 2; ++bj) { const f32x4 x0 = *(const f32x4*)(xb + off + bj * 128), x1 = *(const f32x4*)(xb + off + bj * 128 + 4);
                    *(f32x4*)(out + off + bj * 128) = acc[ai][bj][m][0] + x0; *(f32x4*)(out + off + bj * 128 + 4) = acc[ai][bj][m][1] + x1; } }
    }
};

__device__ __forceinline__ void norm_row_to_bf16(const float* src, const float* w, bf16_t* dst, int lane) {
    const f32x4* s = (const f32x4*)src + lane; const f32x4* wv = (const f32x4*)w + lane;
    f32x4 v[8]; float ss = 0.f;
#pragma unroll
    for (int j = 0; j < 8; ++j) { v[j] = s[64 * j]; ss += (v[j].x * v[j].x + v[j].y * v[j].y) + (v[j].z * v[j].z + v[j].w * v[j].w); }
    const float rstd = 1.0f / sqrtf(wave_sum(ss) * (1.0f / DM) + EPS);
    u32x2* o = (u32x2*)dst + lane;
#pragma unroll
    for (int j = 0; j < 8; ++j) { const f32x4 ww = wv[64 * j]; u32x2 r; r.x = pk2(v[j].x * rstd * ww.x, v[j].y * rstd * ww.y); r.y = pk2(v[j].z * rstd * ww.z, v[j].w * rstd * ww.w); o[64 * j] = r; }
}
__device__ __forceinline__ void transpose_item(const float* W, int ldw, int csrc, bf16_t* WT, int n0, int k0, LAS float* scr, int lane) {
#pragma unroll 8
    for (int i = 0; i < 32; ++i) { const int kk = 2 * i + (lane >> 5); scr[kk * 33 + (lane & 31)] = W[(size_t)(k0 + kk) * ldw + csrc + (lane & 31)]; }
    asm volatile("s_waitcnt lgkmcnt(0)" ::: "memory");
    const int c = lane & 7;
#pragma unroll
    for (int j = 0; j < 4; ++j) { const int n = (lane >> 3) + 8 * j; const LAS float* s = scr + (8 * c) * 33 + n;
        u32x4 o; o.x = pk2(s[0 * 33], s[1 * 33]); o.y = pk2(s[2 * 33], s[3 * 33]); o.z = pk2(s[4 * 33], s[5 * 33]); o.w = pk2(s[6 * 33], s[7 * 33]);
        *(u32x4*)(WT + (size_t)(n0 + n) * DM + k0 + 8 * c) = o; }
    asm volatile("s_waitcnt lgkmcnt(0)" ::: "memory");
}
__device__ __forceinline__ void phase_prep(const Params& p, LAS unsigned char* lds) {
    const int tid = threadIdx.x, lane = tid & 63, wave = tid >> 6;
    const int gw = blockIdx.x * 8 + wave, NGW = gridDim.x * 8;
    unsigned char* ws = p.ws;
    bf16_t* XB = (bf16_t*)(ws + WS_XB); bf16_t* MB = (bf16_t*)(ws + WS_MB);
    for (int r = gw; r < NTOK + NMR; r += NGW) {
        if (r < NP) norm_row_to_bf16(p.x_prompt + (size_t)r * DM, p.norm_w, XB + (size_t)r * DM, lane);
        else if (r < NTOK) norm_row_to_bf16(p.x_sample + (size_t)(r - NP) * DM, p.norm_w, XB + (size_t)r * DM, lane);
        else norm_row_to_bf16(p.mem + (size_t)(r - NTOK) * DM, p.mem_norm_w, MB + (size_t)(r - NTOK) * DM, lane);
    }
    LAS float* scr = (LAS float*)(lds + wave * 8704);
    constexpr int I_IN = 32 * (DINP / 32), I_M = 32 * (1024 / 32), I_O = 32 * (2048 / 32);
    bf16_t* WIN = (bf16_t*)(ws + WS_WIN); bf16_t* WM = (bf16_t*)(ws + WS_WM); bf16_t* WO = (bf16_t*)(ws + WS_WO); bf16_t* WR = (bf16_t*)(ws + WS_WR);
    for (int it = gw; it < I_IN + I_M + I_O; it += NGW) {
        int r = it;
        if (r < I_IN) { const int nb = r % (DINP / 32), kb = r / (DINP / 32), n0 = nb * 32; transpose_item(p.w_in, DIN, n0 + (n0 >= SRC_BR ? 16 : 0), WIN, n0, kb * 64, scr, lane); continue; }
        r -= I_IN;
        if (r < I_M) { const int nb = r % 32, kb = r / 32; transpose_item(p.w_mem, 1024, nb * 32, WM, nb * 32, kb * 64, scr, lane); continue; }
        r -= I_M;
        { const int nb = r % 64, kb = r / 64; transpose_item(p.w_out, 2048, nb * 32, WO, nb * 32, kb * 64, scr, lane); }
    }
    for (int i = blockIdx.x * NTHREADS + tid; i < 16 * DM; i += gridDim.x * NTHREADS) { const int r = i & 15, k = i >> 4; WR[r * DM + k] = (bf16_t)f2bf(p.w_in[(size_t)k * DIN + SRC_BR + r]); }
}

__device__ __forceinline__ void br_task(const bf16_t* XB, const bf16_t* WR, float* BR, int task, int wave, int lane) {
    const int fr = lane & 15, fq = lane >> 4, row0 = task * 128 + wave * 16;
    const bf16_t* ap = XB + (size_t)(row0 + fr) * DM + 8 * fq; const bf16_t* bp = WR + (size_t)fr * DM + 8 * fq;
    f32x4 acc = (f32x4){0.f, 0.f, 0.f, 0.f};
#pragma unroll 8
    for (int k0 = 0; k0 < DM; k0 += 32) { const bf16x8 a = *(const bf16x8*)(ap + k0), b = *(const bf16x8*)(bp + k0); acc = __builtin_amdgcn_mfma_f32_16x16x32_bf16(a, b, acc, 0, 0, 0); }
#pragma unroll
    for (int j = 0; j < 4; ++j) BR[(size_t)(row0 + 4 * fq + j) * 16 + fr] = acc[j];
}

__device__ __forceinline__ void mixA_task(const Params& p, LAS unsigned char* lds, int row0, int h, int L, bool write_cv) {
    int tid_ = threadIdx.x; asm volatile("" : "+v"(tid_)); const int tid = tid_, lane = tid & 63, wave = tid >> 6;
    const bf16_t* PROJ = (const bf16_t*)(p.ws + WS_PROJ); bf16_t* BRANCH = (bf16_t*)(p.ws + WS_BRANCH);
    LAS float* Wl = (LAS float*)lds;
    LAS bf16_t* vn = (LAS bf16_t*)(lds + 65536);
    LAS float* rs = (LAS float*)(lds + 65536 + 49152);
    __syncthreads();
    for (int t = wave * 16; t < wave * 16 + 16; ++t) {
        const u32x2* src = (const u32x2*)(PROJ + (size_t)(row0 + t) * DINP + C_AV) + lane; float ss = 0.f;
#pragma unroll
        for (int j = 0; j < 3; ++j) { const u32x2 w = src[64 * j]; const float a = bflo(w.x), b = bfhi(w.x), c = bflo(w.y), d = bfhi(w.y); ss += (a * a + b * b) + (c * c + d * d); }
        ss = wave_sum(ss);
        if (lane == 0) rs[t] = 1.0f / sqrtf(ss * (1.0f / 768.0f) + EPS);
    }
    for (int i = tid; i < 128 * 32; i += NTHREADS) ((LAS f32x4*)Wl)[i] = ((const f32x4*)(p.a_ws + (size_t)h * 16384))[i];
    __syncthreads();
    for (int i = tid; i < 128 * 192; i += NTHREADS) { const int t = i / 192, dd = i % 192;
        const float v = bf2f(PROJ[(size_t)(row0 + t) * DINP + C_AV + h * 192 + dd]) * rs[t] * p.a_vnorm_w[h * 192 + dd];
        vn[i] = (bf16_t)f2bf(v);
        if (write_cv) p.out[O_CV + (size_t)(row0 - NP + t) * 768 + h * 192 + dd] = v; }
    __syncthreads();
    if (tid < 384) {
        const int dd2 = tid % 96, ig = tid / 96;
        for (int k = 0; k < 32; ++k) {
            const int rl = ig + 4 * k, i = rl % L, cs = rl - i;
            float a0 = 0.f, a1 = 0.f;
            for (int j = 0; j <= i; ++j) { const float w = Wl[i * 128 + j]; const unsigned v = *(const LAS unsigned*)(vn + (cs + j) * 192 + 2 * dd2); a0 += w * bflo(v); a1 += w * bfhi(v); }
            const float bsv = p.a_bs[h * 128 + i]; a0 += bsv; a1 += bsv;
            const size_t rb = (size_t)(row0 + rl) * DINP + h * 192 + 2 * dd2;
            const unsigned uu = *(const unsigned*)(PROJ + rb + C_AU), gg = *(const unsigned*)(PROJ + rb + C_AG);
            const float o0 = bflo(uu) * a0 * silu(bflo(gg)), o1 = bfhi(uu) * a1 * silu(bfhi(gg));
            *(unsigned*)(BRANCH + (size_t)(row0 + rl) * DM + h * 192 + 2 * dd2) = pk2(o0, o1);
        }
    }
}

template <bool F32SRC>
__device__ __forceinline__ void mixX_task(const Params& p, LAS unsigned char* lds, const void* Ksrc, const void* Vsrc, int kvrow0, int h, int qrow0, int nq) {
    int tid_ = threadIdx.x; asm volatile("" : "+v"(tid_)); const int tid = tid_, lane = tid & 63, wave = tid >> 6;
    const bf16_t* PROJ = (const bf16_t*)(p.ws + WS_PROJ); bf16_t* BRANCH = (bf16_t*)(p.ws + WS_BRANCH);
    LAS unsigned char* Kl = lds;
    LAS unsigned char* Vl = lds + 69632;
    LAS float* qs = (LAS float*)(lds + 69632 + 65536) + wave * 128;
    LAS float* ps = (LAS float*)(lds + 69632 + 65536 + 4096) + wave * 256;
    __syncthreads();
    if (F32SRC) {
        const float* K = (const float*)Ksrc; const float* V = (const float*)Vsrc;
        for (int i = tid; i < 256 * 32; i += NTHREADS) { const int n = i >> 5, ch = i & 31; const size_t g = (size_t)(kvrow0 + n) * 512 + h * 128 + ch * 4;
            const f32x4 kv = *(const f32x4*)(K + g), vv = *(const f32x4*)(V + g);
            u32x2 a; a.x = pk2(kv.x, kv.y); a.y = pk2(kv.z, kv.w); *(LAS u32x2*)(Kl + n * 272 + ch * 8) = a;
            u32x2 b; b.x = pk2(vv.x, vv.y); b.y = pk2(vv.z, vv.w); *(LAS u32x2*)(Vl + n * 256 + ch * 8) = b; }
    } else {
        const bf16_t* K = (const bf16_t*)Ksrc; const bf16_t* V = (const bf16_t*)Vsrc;
        for (int i = tid; i < 256 * 16; i += NTHREADS) { const int n = i >> 4, ch = i & 15; const size_t g = (size_t)(kvrow0 + n) * 512 + h * 128 + ch * 8;
            *(LAS u32x4*)(Kl + n * 272 + ch * 16) = *(const u32x4*)(K + g); *(LAS u32x4*)(Vl + n * 256 + ch * 16) = *(const u32x4*)(V + g); }
    }
    __syncthreads();
    for (int qi = wave; qi < nq; qi += 8) {
        const int row = qrow0 + qi;
        { const unsigned w = *(const unsigned*)(PROJ + (size_t)row * DINP + C_XQ + h * 128 + 2 * lane); qs[2 * lane] = bflo(w) * 0.08838834764831845f; qs[2 * lane + 1] = bfhi(w) * 0.08838834764831845f; }
        asm volatile("s_waitcnt lgkmcnt(0)" ::: "memory");
        float s[4] = {0.f, 0.f, 0.f, 0.f};
        for (int c = 0; c < 16; ++c) {
            const f32x4 qa = *(const LAS f32x4*)(qs + 8 * c), qb = *(const LAS f32x4*)(qs + 8 * c + 4);
#pragma unroll
            for (int kk = 0; kk < 4; ++kk) { const u32x4 kv = *(const LAS u32x4*)(Kl + (lane + 64 * kk) * 272 + c * 16);
                s[kk] += (qa.x * bflo(kv.x) + qa.y * bfhi(kv.x)) + (qa.z * bflo(kv.y) + qa.w * bfhi(kv.y)) + (qb.x * bflo(kv.z) + qb.y * bfhi(kv.z)) + (qb.z * bflo(kv.w) + qb.w * bfhi(kv.w)); }
        }
        const float mx = wave_max(fmaxf(fmaxf(s[0], s[1]), fmaxf(s[2], s[3])));
        float e[4], sum = 0.f;
#pragma unroll
        for (int kk = 0; kk < 4; ++kk) { e[kk] = __expf(s[kk] - mx); sum += e[kk]; }
        const float inv = 1.0f / wave_sum(sum);
#pragma unroll
        for (int kk = 0; kk < 4; ++kk) ps[lane + 64 * kk] = e[kk] * inv;
        asm volatile("s_waitcnt lgkmcnt(0)" ::: "memory");
        float o0 = 0.f, o1 = 0.f;
        for (int n = 0; n < 256; n += 4) { const f32x4 pp = *(const LAS f32x4*)(ps + n);
#pragma unroll
            for (int j = 0; j < 4; ++j) { const unsigned v = *(const LAS unsigned*)(Vl + (n + j) * 256 + lane * 4); o0 += pp[j] * bflo(v); o1 += pp[j] * bfhi(v); } }
        const unsigned g = *(const unsigned*)(PROJ + (size_t)row * DINP + C_XG + h * 128 + 2 * lane);
        *(unsigned*)(BRANCH + (size_t)row * DM + 1536 + h * 128 + 2 * lane) = pk2(o0 * silu(bflo(g)), o1 * silu(bfhi(g)));
    }
}


__device__ __forceinline__ void mixA2_task(const Params& p, LAS unsigned char* lds, int row0, int h, int L, bool smp) {
    int tid_ = threadIdx.x; asm volatile("" : "+v"(tid_)); const int tid = tid_, lane = tid & 63, w = __builtin_amdgcn_readfirstlane(tid >> 6), fr = lane & 15, fq = lane >> 4;
    const bf16_t* PROJ = (const bf16_t*)(p.ws + WS_PROJ); bf16_t* BRANCH = (bf16_t*)(p.ws + WS_BRANCH);
    LAS unsigned char* Wl = lds;
    LAS unsigned char* vnl = lds + 34816;
    LAS float* rs = (LAS float*)(lds + 34816 + 53248);
    __syncthreads();
    for (int t = w * 16; t < w * 16 + 16; ++t) {
        const u32x2* src = (const u32x2*)(PROJ + (size_t)(row0 + t) * DINP + C_AV) + lane; float ss = 0.f;
#pragma unroll
        for (int j = 0; j < 3; ++j) { const u32x2 x = src[64 * j]; const float a = bflo(x.x), b = bfhi(x.x), c = bflo(x.y), d = bfhi(x.y); ss += (a * a + b * b) + (c * c + d * d); }
        ss = wave_sum(ss);
        if (lane == 0) rs[t] = 1.0f / sqrtf(ss * (1.0f / 768.0f) + EPS);
    }
#pragma unroll
    for (int k = 0; k < 8; ++k) { const int idx = tid + 512 * k, i = idx >> 5, j4 = (idx & 31) * 4; float v[4];
        if (!smp) { const f32x4 x = *(const f32x4*)(p.a_ws + (size_t)h * 16384 + i * 128 + j4);
#pragma unroll
            for (int q = 0; q < 4; ++q) v[q] = (j4 + q <= i) ? x[q] : 0.f; }
        else {
#pragma unroll
            for (int q = 0; q < 4; ++q) { const int j = j4 + q; v[q] = ((j >> 3) == (i >> 3) && (j & 7) <= (i & 7)) ? p.a_ws[(size_t)h * 16384 + (i & 7) * 128 + (j & 7)] : 0.f; } }
        u32x2 o; o.x = pk2(v[0], v[1]); o.y = pk2(v[2], v[3]); *(LAS u32x2*)(Wl + i * 272 + j4 * 2) = o; }
    __syncthreads();
#pragma unroll
    for (int k = 0; k < 6; ++k) { const int idx = tid + 512 * k, t = idx / 24, ch = idx % 24;
        const u32x4 x = *(const u32x4*)(PROJ + (size_t)(row0 + t) * DINP + C_AV + h * 192 + 8 * ch);
        const f32x4 w0 = *(const f32x4*)(p.a_vnorm_w + h * 192 + 8 * ch), w1 = *(const f32x4*)(p.a_vnorm_w + h * 192 + 8 * ch + 4); const float r = rs[t];
        f32x4 v0, v1; v0[0] = bflo(x.x) * r * w0[0]; v0[1] = bfhi(x.x) * r * w0[1]; v0[2] = bflo(x.y) * r * w0[2]; v0[3] = bfhi(x.y) * r * w0[3];
        v1[0] = bflo(x.z) * r * w1[0]; v1[1] = bfhi(x.z) * r * w1[1]; v1[2] = bflo(x.w) * r * w1[2]; v1[3] = bfhi(x.w) * r * w1[3];
        u32x4 o; o.x = pk2(v0[0], v0[1]); o.y = pk2(v0[2], v0[3]); o.z = pk2(v1[0], v1[1]); o.w = pk2(v1[2], v1[3]);
        *(LAS u32x4*)(vnl + t * 416 + ch * 16) = o;
        if (smp) { float* cv = p.out + O_CV + (size_t)(row0 - NP + t) * 768 + h * 192 + 8 * ch; *(f32x4*)cv = v0; *(f32x4*)(cv + 4) = v1; } }
    __syncthreads();
    {
        const int it = w;
        const int ks_lo = smp ? (it >> 1) : 0, ks_hi = smp ? (it >> 1) : ((16 * it + 15) >> 5);
        f32x4 acc[12];
#pragma unroll
        for (int dt = 0; dt < 12; ++dt) acc[dt] = (f32x4){0.f, 0.f, 0.f, 0.f};
        const unsigned vbase = (unsigned)(size_t)vnl + (unsigned)((4 * fq + (fr >> 2)) * 416 + (4 * (fr & 3)) * 2);
        for (int ks = ks_lo; ks <= ks_hi; ++ks) {
            const u32x2 wlo = *(const LAS u32x2*)(Wl + (16 * it + fr) * 272 + (32 * ks + 4 * fq) * 2), whi = *(const LAS u32x2*)(Wl + (16 * it + fr) * 272 + (32 * ks + 16 + 4 * fq) * 2);
            u32x4 wy; wy.x = wlo.x; wy.y = wlo.y; wy.z = whi.x; wy.w = whi.y; const bf16x8 yf = __builtin_bit_cast(bf16x8, wy);
#pragma unroll
            for (int g = 0; g < 3; ++g) { s16x4 lo[4], hi[4];
#pragma unroll
                for (int q = 0; q < 4; ++q) { const unsigned a = vbase + (unsigned)(32 * ks * 416 + (16 * (4 * g + q)) * 2); lo[q] = tr_read(a); hi[q] = tr_read(a + 16 * 416); }
                TR_WAIT();
#pragma unroll
                for (int q = 0; q < 4; ++q) acc[4 * g + q] = MFMA16(PK8(lo[q], hi[q]), yf, acc[4 * g + q]); }
        }
        const int i = 16 * it + fr; const size_t row = (size_t)(row0 + i); const float bsv = p.a_bs[h * 128 + (i % L)];
#pragma unroll
        for (int dt = 0; dt < 12; ++dt) { const int dd0 = 16 * dt + 4 * fq;
            const u32x2 uu = *(const u32x2*)(PROJ + row * DINP + C_AU + h * 192 + dd0), gg = *(const u32x2*)(PROJ + row * DINP + C_AG + h * 192 + dd0);
            u32x2 o; o.x = pk2(bflo(uu.x) * (acc[dt][0] + bsv) * silu(bflo(gg.x)), bfhi(uu.x) * (acc[dt][1] + bsv) * silu(bfhi(gg.x)));
            o.y = pk2(bflo(uu.y) * (acc[dt][2] + bsv) * silu(bflo(gg.y)), bfhi(uu.y) * (acc[dt][3] + bsv) * silu(bfhi(gg.y)));
            *(u32x2*)(BRANCH + row * DM + h * 192 + dd0) = o; }
    }
}

__device__ __forceinline__ void mixXp_task(const Params& p, LAS unsigned char* lds, int b, int h, int qt) {
    int tid_ = threadIdx.x; asm volatile("" : "+v"(tid_)); const int tid = tid_, lane = tid & 63, w = __builtin_amdgcn_readfirstlane(tid >> 6), fr = lane & 15, fq = lane >> 4;
    const bf16_t* PROJ = (const bf16_t*)(p.ws + WS_PROJ); bf16_t* BRANCH = (bf16_t*)(p.ws + WS_BRANCH);
    const bf16_t* MKB = (const bf16_t*)(p.ws + WS_MKB); const bf16_t* MVB = (const bf16_t*)(p.ws + WS_MVB);
    LAS unsigned char* Kl = lds;
    LAS unsigned char* Vl = lds + 69632;
    __syncthreads();
#pragma unroll
    for (int k = 0; k < 8; ++k) { const int idx = tid + 512 * k, n = idx >> 4, ch = idx & 15; const size_t g = (size_t)(b * 256 + n) * 512 + h * 128 + ch * 8;
        *(LAS u32x4*)(Kl + n * 272 + ch * 16) = *(const u32x4*)(MKB + g); *(LAS u32x4*)(Vl + n * 288 + ch * 16) = *(const u32x4*)(MVB + g); }
    const size_t row = (size_t)(b * SEQ + qt * 128 + 16 * w + fr);
    bf16x8 bQ[4];
#pragma unroll
    for (int ks = 0; ks < 4; ++ks) bQ[ks] = *(const bf16x8*)(PROJ + row * DINP + C_XQ + h * 128 + 32 * ks + 8 * fq);
    __syncthreads();
    f32x4 s[16];
#pragma unroll
    for (int nt = 0; nt < 16; ++nt) { f32x4 a = (f32x4){0.f, 0.f, 0.f, 0.f};
#pragma unroll
        for (int ks = 0; ks < 4; ++ks) a = MFMA16(*(const LAS bf16x8*)(Kl + (16 * nt + fr) * 272 + (32 * ks + 8 * fq) * 2), bQ[ks], a);
        s[nt] = a; }
    float mx = -3.0e38f;
#pragma unroll
    for (int nt = 0; nt < 16; ++nt) mx = fmaxf(mx, fmaxf(fmaxf(s[nt][0], s[nt][1]), fmaxf(s[nt][2], s[nt][3])));
    mx = fmaxf(mx, __shfl_xor(mx, 16)); mx = fmaxf(mx, __shfl_xor(mx, 32));
    float l = 0.f; bf16x8 pP[8];
#pragma unroll
    for (int ks = 0; ks < 8; ++ks) { float e[8];
#pragma unroll
        for (int j = 0; j < 4; ++j) { e[j] = __expf((s[2 * ks][j] - mx) * 0.08838834764831845f); e[4 + j] = __expf((s[2 * ks + 1][j] - mx) * 0.08838834764831845f); }
        u32x4 pw; pw.x = pk2(e[0], e[1]); pw.y = pk2(e[2], e[3]); pw.z = pk2(e[4], e[5]); pw.w = pk2(e[6], e[7]); pP[ks] = __builtin_bit_cast(bf16x8, pw);
        l += ((e[0] + e[1]) + (e[2] + e[3])) + ((e[4] + e[5]) + (e[6] + e[7])); }
    l += __shfl_xor(l, 16); l += __shfl_xor(l, 32);
    const float inv = 1.0f / l;
    const unsigned vbase = (unsigned)(size_t)Vl + (unsigned)((4 * fq + (fr >> 2)) * 288 + (4 * (fr & 3)) * 2);
#pragma unroll
    for (int dt = 0; dt < 8; ++dt) {
        const u32x2 gg = *(const u32x2*)(PROJ + row * DINP + C_XG + h * 128 + 16 * dt + 4 * fq);
        f32x4 o = (f32x4){0.f, 0.f, 0.f, 0.f};
#pragma unroll
        for (int half = 0; half < 2; ++half) { s16x4 lo[4], hi[4];
#pragma unroll
            for (int q = 0; q < 4; ++q) { const unsigned a = vbase + (unsigned)((32 * (4 * half + q)) * 288 + (16 * dt) * 2); lo[q] = tr_read(a); hi[q] = tr_read(a + 16 * 288); }
            TR_WAIT();
#pragma unroll
            for (int q = 0; q < 4; ++q) o = MFMA16(PK8(lo[q], hi[q]), pP[4 * half + q], o); }
        u32x2 ow; ow.x = pk2(o[0] * inv * silu(bflo(gg.x)), o[1] * inv * silu(bfhi(gg.x))); ow.y = pk2(o[2] * inv * silu(bflo(gg.y)), o[3] * inv * silu(bfhi(gg.y)));
        *(u32x2*)(BRANCH + row * DM + 1536 + h * 128 + 16 * dt + 4 * fq) = ow;
    }
}

__device__ __forceinline__ void mixXs_task(const Params& p, LAS unsigned char* lds, int b, int h) {
    int tid_ = threadIdx.x; asm volatile("" : "+v"(tid_)); const int tid = tid_, lane = tid & 63, w = __builtin_amdgcn_readfirstlane(tid >> 6), fr = lane & 15, fq = lane >> 4;
    const bf16_t* PROJ = (const bf16_t*)(p.ws + WS_PROJ); bf16_t* BRANCH = (bf16_t*)(p.ws + WS_BRANCH);
    LAS float* part = (LAS float*)lds;
    LAS float* ml = (LAS float*)(lds + 32768);
    __syncthreads();
    const float* vp = p.cache_v + (size_t)(b * 256 + 32 * w) * 512 + h * 128 + 2 * lane;
    f32x2 vv[32];
#pragma unroll
    for (int kk = 0; kk < 32; ++kk) vv[kk] = *(const f32x2*)(vp + (size_t)kk * 512);
    const size_t qrow = (size_t)(NP + b * 8 + (fr & 7));
    bf16x8 bQ[4];
#pragma unroll
    for (int ks = 0; ks < 4; ++ks) bQ[ks] = *(const bf16x8*)(PROJ + qrow * DINP + C_XQ + h * 128 + 32 * ks + 8 * fq);
    f32x4 s[2];
#pragma unroll
    for (int nt = 0; nt < 2; ++nt) { const float* kp = p.cache_k + (size_t)(b * 256 + 32 * w + 16 * nt + fr) * 512 + h * 128 + 8 * fq; f32x4 a = (f32x4){0.f, 0.f, 0.f, 0.f};
        f32x4 k0[4], k1[4];
#pragma unroll
        for (int ks = 0; ks < 4; ++ks) { k0[ks] = *(const f32x4*)(kp + 32 * ks); k1[ks] = *(const f32x4*)(kp + 32 * ks + 4); }
#pragma unroll
        for (int ks = 0; ks < 4; ++ks) { u32x4 kw; kw.x = pk2(k0[ks][0], k0[ks][1]); kw.y = pk2(k0[ks][2], k0[ks][3]); kw.z = pk2(k1[ks][0], k1[ks][1]); kw.w = pk2(k1[ks][2], k1[ks][3]);
            a = MFMA16(__builtin_bit_cast(bf16x8, kw), bQ[ks], a); }
        s[nt] = a * 0.08838834764831845f; }
    float mx = fmaxf(fmaxf(fmaxf(s[0][0], s[0][1]), fmaxf(s[0][2], s[0][3])), fmaxf(fmaxf(s[1][0], s[1][1]), fmaxf(s[1][2], s[1][3])));
    mx = fmaxf(mx, __shfl_xor(mx, 16)); mx = fmaxf(mx, __shfl_xor(mx, 32));
    float l = 0.f;
#pragma unroll
    for (int nt = 0; nt < 2; ++nt)
#pragma unroll
        for (int j = 0; j < 4; ++j) { s[nt][j] = __expf(s[nt][j] - mx); l += s[nt][j]; }
    l += __shfl_xor(l, 16); l += __shfl_xor(l, 32);
    if (lane < 8) { ml[(w * 8 + lane) * 2] = mx; ml[(w * 8 + lane) * 2 + 1] = l; }
    f32x2 acc[8];
#pragma unroll
    for (int i = 0; i < 8; ++i) acc[i] = (f32x2){0.f, 0.f};
#pragma unroll
    for (int kk = 0; kk < 32; ++kk) { const int nt = kk >> 4, fqs = (kk & 15) >> 2, j = kk & 3;
        const float sv = s[nt][j]; const int svi = __float_as_int(sv);
#pragma unroll
        for (int i = 0; i < 8; ++i) { const float pv = __int_as_float(__builtin_amdgcn_readlane(svi, i + 16 * fqs)); acc[i] += vv[kk] * pv; } }
#pragma unroll
    for (int i = 0; i < 8; ++i) *(LAS f32x2*)(part + (w * 8 + i) * 128 + 2 * lane) = acc[i];
    __syncthreads();
    { const int i = tid >> 6, dd = 2 * (tid & 63); float M = -3.0e38f;
#pragma unroll
      for (int ww = 0; ww < 8; ++ww) M = fmaxf(M, ml[(ww * 8 + i) * 2]);
      float Lq = 0.f, o0 = 0.f, o1 = 0.f;
#pragma unroll
      for (int ww = 0; ww < 8; ++ww) { const float sc = __expf(ml[(ww * 8 + i) * 2] - M); Lq += ml[(ww * 8 + i) * 2 + 1] * sc; const f32x2 pa = *(const LAS f32x2*)(part + (ww * 8 + i) * 128 + dd); o0 += pa.x * sc; o1 += pa.y * sc; }
      const size_t row = (size_t)(NP + b * 8 + i); const unsigned g = *(const unsigned*)(PROJ + row * DINP + C_XG + h * 128 + dd); const float inv = 1.0f / Lq;
      *(unsigned*)(BRANCH + row * DM + 1536 + h * 128 + dd) = pk2(o0 * inv * silu(bflo(g)), o1 * inv * silu(bfhi(g))); }
}

__device__ __forceinline__ void mixB_task(const Params& p, LAS unsigned char* lds, int row0, int T, int h, const float* s0, float* sout) {
    int tid_ = threadIdx.x; asm volatile("" : "+v"(tid_)); const int tid = tid_, lane = tid & 63, wave = tid >> 6;
    const bf16_t* PROJ = (const bf16_t*)(p.ws + WS_PROJ); bf16_t* BRANCH = (bf16_t*)(p.ws + WS_BRANCH); const float* BR = (const float*)(p.ws + WS_BR);
    LAS float* qs = (LAS float*)lds;
    LAS float* ks = qs + 32 * 96;
    LAS float* al = ks + 32 * 96;
    LAS float* vs = al + 32 * 96;
    LAS float* po = vs + 32 * 192;
    const int e = tid % 192, hf = tid / 192, d0 = hf * 48;
    float S[48];
#pragma unroll
    for (int dd = 0; dd < 48; ++dd) S[dd] = (s0 && tid < 384) ? s0[(size_t)(d0 + dd) * 192 + e] : 0.f;
    const int TC = T < 32 ? T : 32;
    for (int t0 = 0; t0 < T; t0 += TC) {
        __syncthreads();
        for (int i = tid; i < TC * 96; i += NTHREADS) { const int t = i / 96, d = i % 96; const size_t row = (size_t)(row0 + t0 + t);
            float z = p.b_ba[h * 96 + d];
#pragma unroll
            for (int r = 0; r < 16; ++r) z += BR[row * 16 + r] * p.b_wa[r * 384 + h * 96 + d];
            const float la = (fminf(z, 0.f) - log1pf(__expf(-fabsf(z)))) * (1.0f / 16.0f);
            al[i] = __expf(la);
            qs[i] = bf2f(PROJ[row * DINP + C_BQ + h * 96 + d]) * 0.10206207261596577f;
            ks[i] = bf2f(PROJ[row * DINP + C_BK + h * 96 + d]); }
        for (int i = tid; i < TC * 192; i += NTHREADS) { const int t = i / 192, ee = i % 192; vs[i] = bf2f(PROJ[(size_t)(row0 + t0 + t) * DINP + C_BV + h * 192 + ee]); }
        __syncthreads();
        if (tid < 384) {
#pragma unroll 1
            for (int t = 0; t < TC; ++t) {
                const float v = vs[t * 192 + e]; float acc = 0.f;
#pragma unroll
                for (int d4 = 0; d4 < 12; ++d4) {
                    const f32x4 a4 = *(const LAS f32x4*)(al + t * 96 + d0 + 4 * d4), k4 = *(const LAS f32x4*)(ks + t * 96 + d0 + 4 * d4), q4 = *(const LAS f32x4*)(qs + t * 96 + d0 + 4 * d4);
#pragma unroll
                    for (int j = 0; j < 4; ++j) { S[4 * d4 + j] = a4[j] * S[4 * d4 + j] + k4[j] * v; acc += q4[j] * S[4 * d4 + j]; }
                    if ((d4 % 3) == 2) asm volatile("" ::: "memory");
                }
                po[(hf * 32 + t) * 192 + e] = acc;
            }
        }
        __syncthreads();
        for (int t = wave; t < TC; t += 8) {
            const size_t row = (size_t)(row0 + t0 + t);
            float o[3], ss = 0.f;
#pragma unroll
            for (int j = 0; j < 3; ++j) { o[j] = po[t * 192 + lane + 64 * j] + po[(32 + t) * 192 + lane + 64 * j]; ss += o[j] * o[j]; }
            const float rstd = 1.0f / sqrtf(wave_sum(ss) * (1.0f / 192.0f) + EPS);
#pragma unroll
            for (int j = 0; j < 3; ++j) { const int ee = lane + 64 * j; const float g = bf2f(PROJ[row * DINP + C_BG + h * 192 + ee]);
                BRANCH[row * DM + 768 + h * 192 + ee] = (bf16_t)f2bf(o[j] * rstd * p.b_onorm_w[ee] * silu(g)); }
        }
    }
    if (tid < 384) {
#pragma unroll
        for (int dd = 0; dd < 48; ++dd) sout[(size_t)(d0 + dd) * 192 + e] = S[dd];
    }
}


__device__ __forceinline__ void glaPrep_task(const Params& p, LAS unsigned char* lds, int b, int h, int c) {
    int tid_ = threadIdx.x; asm volatile("" : "+v"(tid_)); const int tid = tid_, lane = tid & 63, w = __builtin_amdgcn_readfirstlane(tid >> 6), fr = lane & 15, fq = lane >> 4;
    LAS bf16_t* Qh  = (LAS bf16_t*)lds;
    LAS bf16_t* Kin = (LAS bf16_t*)(lds + 13312);
    LAS unsigned char* Ko = lds + 26624;
    LAS unsigned char* Vl = lds + 40960;
    LAS bf16_t* Pm  = (LAS bf16_t*)(lds + 67584);
    LAS bf16_t* laH = (LAS bf16_t*)(lds + 76800);
    LAS bf16_t* laL = (LAS bf16_t*)(lds + 90624);
    LAS float* gex  = (LAS float*)(lds + 104448);
    LAS float* bav  = (LAS float*)(lds + 104832);
    LAS unsigned char* WF = lds + 105216;
    const bf16_t* PROJ = (const bf16_t*)(p.ws + WS_PROJ); const float* BR = (const float*)(p.ws + WS_BR);
    bf16_t* QHg = (bf16_t*)(p.ws + WS_QH); bf16_t* KOg = (bf16_t*)(p.ws + WS_KO); bf16_t* VTg = (bf16_t*)(p.ws + WS_VT); bf16_t* OIg = (bf16_t*)(p.ws + WS_OI); bf16_t* GFg = (bf16_t*)(p.ws + WS_GF);
    float* GXg = (float*)(p.ws + WS_GX);
    const int row0 = b * SEQ + c * 64, bhc = (b * 4 + h) * 32 + c;
    const int it = w & 3, dt0 = 3 * (w >> 2);
    __syncthreads();
    const size_t rowi = (size_t)(row0 + 16 * it + fr);
    u32x2 qv[3], kv[3]; f32x4 brv[2]; u32x4 vv[3];
    { const bf16_t* qkp = PROJ + rowi * DINP + C_BQ + h * 96 + 16 * dt0 + 4 * fq;
#pragma unroll
      for (int n = 0; n < 3; ++n) { qv[n] = *(const u32x2*)(qkp + 16 * n); kv[n] = *(const u32x2*)(qkp + 384 + 16 * n); }
      const float* brp = BR + rowi * 16 + 8 * (fq & 1); brv[0] = *(const f32x4*)brp; brv[1] = *(const f32x4*)(brp + 4);
      const bf16_t* vp = PROJ + (size_t)(row0 + (tid >> 3)) * DINP + C_BV + h * 192 + 8 * (tid & 7);
#pragma unroll
      for (int k = 0; k < 3; ++k) vv[k] = *(const u32x4*)(vp + 64 * k); }
    if (tid < 192) { const int dt = tid >> 5, l32 = tid & 31, d = 16 * dt + (l32 & 15), r0 = 8 * (l32 >> 4); float hi[8], lo[8];
#pragma unroll
        for (int jj = 0; jj < 8; ++jj) { const float wv = p.b_wa[(r0 + jj) * 384 + h * 96 + d]; hi[jj] = bf2f((bf16_t)f2bf(wv)); lo[jj] = wv - hi[jj]; }
        u32x4 a, cc; a.x = pk2(hi[0], hi[1]); a.y = pk2(hi[2], hi[3]); a.z = pk2(hi[4], hi[5]); a.w = pk2(hi[6], hi[7]);
        cc.x = pk2(lo[0], lo[1]); cc.y = pk2(lo[2], lo[3]); cc.z = pk2(lo[4], lo[5]); cc.w = pk2(lo[6], lo[7]);
        *(LAS u32x4*)(WF + tid * 16) = a; *(LAS u32x4*)(WF + 3072 + tid * 16) = cc; }
    for (int i = tid; i < 96; i += NTHREADS) bav[i] = p.b_ba[h * 96 + i];
#pragma unroll
    for (int k = 0; k < 6; ++k) { const int idx = tid + 512 * k, t = idx / 48, e4 = 4 * (idx % 48); const size_t row = (size_t)(row0 + t);
        const u32x2 g = *(const u32x2*)(PROJ + row * DINP + C_BG + h * 192 + e4); const f32x4 ow = *(const f32x4*)(p.b_onorm_w + e4);
        u32x2 o; o.x = pk2(ow[0] * silu(bflo(g.x)), ow[1] * silu(bfhi(g.x))); o.y = pk2(ow[2] * silu(bflo(g.y)), ow[3] * silu(bfhi(g.y)));
        *(u32x2*)(GFg + row * 768 + h * 192 + e4) = o; }
#pragma unroll
    for (int k = 0; k < 3; ++k) *(LAS u32x4*)(Vl + (tid >> 3) * 416 + ((tid & 7) + 8 * k) * 16) = vv[k];
    __syncthreads();
    {
        float f[8] = {brv[0].x, brv[0].y, brv[0].z, brv[0].w, brv[1].x, brv[1].y, brv[1].z, brv[1].w};
        float fh[8];
#pragma unroll
        for (int jj = 0; jj < 8; ++jj) { fh[jj] = bf2f((bf16_t)f2bf(f[jj])); if (fq >= 2) fh[jj] = f[jj] - fh[jj]; }
        u32x4 bw; bw.x = pk2(fh[0], fh[1]); bw.y = pk2(fh[2], fh[3]); bw.z = pk2(fh[4], fh[5]); bw.w = pk2(fh[6], fh[7]); const bf16x8 bfrag = __builtin_bit_cast(bf16x8, bw);
#pragma unroll
        for (int n = 0; n < 3; ++n) {
            const int wo = ((dt0 + n) * 32 + (fq & 1) * 16 + fr) * 16;
            const bf16x8 a1 = *(const LAS bf16x8*)(WF + wo); bf16x8 a2 = *(const LAS bf16x8*)(WF + 3072 + wo);
            if (fq >= 2) a2 = (bf16x8){0, 0, 0, 0, 0, 0, 0, 0};
            f32x4 zt = MFMA16(a1, bfrag, ((f32x4){0.f, 0.f, 0.f, 0.f})); zt = MFMA16(a2, bfrag, zt);
            const f32x4 b4 = *(const LAS f32x4*)(bav + 16 * (dt0 + n) + 4 * fq);
#pragma unroll
            for (int j = 0; j < 4; ++j) { const float z = zt[j] + b4[j]; const float la = (fminf(z, 0.f) - __logf(1.0f + __expf(-fabsf(z)))) * 0.0625f;
                const unsigned hi = f2bf(la), lo = f2bf(la - bf2f((bf16_t)hi)); const int o = (16 * (dt0 + n) + 4 * fq + j) * 72 + 16 * it + fr;
                laH[o] = (bf16_t)hi; laL[o] = (bf16_t)lo; }
        }
    }
    __syncthreads();
    f32x4 cu[3];
#pragma unroll
    for (int n = 0; n < 3; ++n) cu[n] = (f32x4){0.f, 0.f, 0.f, 0.f};
#pragma unroll
    for (int ks = 0; ks < 2; ++ks) if (ks == 0 || it >= 2) {
        bf16x8 lt;
#pragma unroll
        for (int jj = 0; jj < 8; ++jj) lt[jj] = ((32 * ks + 8 * fq + jj) <= (16 * it + fr)) ? (short)0x3F80 : (short)0;
#pragma unroll
        for (int n = 0; n < 3; ++n) { const int o = (16 * (dt0 + n) + fr) * 72 + 32 * ks + 8 * fq;
            cu[n] = MFMA16(*(const LAS bf16x8*)(laH + o), lt, cu[n]); cu[n] = MFMA16(*(const LAS bf16x8*)(laL + o), lt, cu[n]); }
    }
    if (it == 3 && fr == 15) {
#pragma unroll
        for (int n = 0; n < 3; ++n) { f32x4 ge; ge[0] = __expf(cu[n][0]); ge[1] = __expf(cu[n][1]); ge[2] = __expf(cu[n][2]); ge[3] = __expf(cu[n][3]);
            *(LAS f32x4*)(gex + 16 * (dt0 + n) + 4 * fq) = ge; *(f32x4*)(GXg + (size_t)bhc * 96 + 16 * (dt0 + n) + 4 * fq) = ge; }
    }
    __syncthreads();
    {
        const int i = 16 * it + fr;
#pragma unroll
        for (int n = 0; n < 3; ++n) {
            const int d = 16 * (dt0 + n) + 4 * fq;
            const f32x4 gxv = *(const LAS f32x4*)(gex + d);
            const float qf[4] = {bflo(qv[n].x), bfhi(qv[n].x), bflo(qv[n].y), bfhi(qv[n].y)}, kf[4] = {bflo(kv[n].x), bfhi(kv[n].x), bflo(kv[n].y), bfhi(kv[n].y)};
            float qh[4], ki[4], ko[4];
#pragma unroll
            for (int j = 0; j < 4; ++j) { const float cc = cu[n][j]; qh[j] = qf[j] * 0.10206207261596577f * __expf(cc); ki[j] = kf[j] * __expf(-cc); ko[j] = ki[j] * gxv[j]; }
            u32x2 wq, wk, wo; wq.x = pk2(qh[0], qh[1]); wq.y = pk2(qh[2], qh[3]); wk.x = pk2(ki[0], ki[1]); wk.y = pk2(ki[2], ki[3]); wo.x = pk2(ko[0], ko[1]); wo.y = pk2(ko[2], ko[3]);
            *(LAS u32x2*)(Qh + i * 104 + d) = wq; *(LAS u32x2*)(Kin + i * 104 + d) = wk; *(LAS u32x2*)(Ko + i * 224 + d * 2) = wo;
            *(u32x2*)(QHg + rowi * 384 + h * 96 + d) = wq;
        }
    }
    __syncthreads();
    {
        const int ita = w >> 1;
#pragma unroll
        for (int j2 = 0; j2 < 2; ++j2) { const int jt = 2 * (w & 1) + j2; u32x2 wp; wp.x = 0u; wp.y = 0u;
            if (jt <= ita) { f32x4 pt = (f32x4){0.f, 0.f, 0.f, 0.f};
#pragma unroll
                for (int ks = 0; ks < 3; ++ks) pt = MFMA16(*(const LAS bf16x8*)(Kin + (16 * jt + fr) * 104 + 32 * ks + 8 * fq), *(const LAS bf16x8*)(Qh + (16 * ita + fr) * 104 + 32 * ks + 8 * fq), pt);
                if (jt == ita) {
#pragma unroll
                    for (int j = 0; j < 4; ++j) if (4 * fq + j > fr) pt[j] = 0.f; }
                wp.x = pk2(pt[0], pt[1]); wp.y = pk2(pt[2], pt[3]); }
            *(LAS u32x2*)(Pm + (16 * ita + fr) * 72 + 16 * jt + 4 * fq) = wp; }
        const int dtk = w < 6 ? w : 0;
        const unsigned kb = (unsigned)(size_t)Ko + (unsigned)((4 * fq + (fr >> 2)) * 224 + (16 * dtk + 4 * (fr & 3)) * 2);
        const s16x4 l0 = tr_read(kb), h0 = tr_read(kb + 16 * 224), l1 = tr_read(kb + 32 * 224), h1 = tr_read(kb + 48 * 224);
        TR_WAIT();
        if (w < 6) { bf16_t* kg = KOg + ((size_t)bhc * 12 + w * 2) * 512 + lane * 8; *(bf16x8*)kg = PK8(l0, h0); *(bf16x8*)(kg + 512) = PK8(l1, h1); }
    }
    __syncthreads();
    {
        const LAS unsigned char* prow = (const LAS unsigned char*)Pm + (16 * it + fr) * 144 + 8 * fq;
        u32x4 y0, y1; { const u32x2 a = *(const LAS u32x2*)(prow), bq = *(const LAS u32x2*)(prow + 32), cq = *(const LAS u32x2*)(prow + 64), dq = *(const LAS u32x2*)(prow + 96);
            y0.x = a.x; y0.y = a.y; y0.z = bq.x; y0.w = bq.y; y1.x = cq.x; y1.y = cq.y; y1.z = dq.x; y1.w = dq.y; }
        const bf16x8 yP0 = __builtin_bit_cast(bf16x8, y0), yP1 = __builtin_bit_cast(bf16x8, y1);
        const unsigned vb = (unsigned)(size_t)Vl + (unsigned)((4 * fq + (fr >> 2)) * 416 + (96 * (w >> 2) + 4 * (fr & 3)) * 2);
        bf16_t* og = OIg + rowi * 768 + h * 192 + 96 * (w >> 2) + 4 * fq;
        bf16_t* vg = VTg + ((size_t)bhc * 24 + 12 * (w >> 2)) * 512 + lane * 8;
#pragma unroll
        for (int g = 0; g < 2; ++g) { s16x4 l0[3], h0[3], l1[3], h1[3];
#pragma unroll
            for (int q = 0; q < 3; ++q) { const unsigned a = vb + (unsigned)((16 * (3 * g + q)) * 2); l0[q] = tr_read(a); h0[q] = tr_read(a + 16 * 416); l1[q] = tr_read(a + 32 * 416); h1[q] = tr_read(a + 48 * 416); }
            TR_WAIT();
#pragma unroll
            for (int q = 0; q < 3; ++q) { const int m = 3 * g + q; const bf16x8 x0 = PK8(l0[q], h0[q]), x1 = PK8(l1[q], h1[q]);
                f32x4 o = MFMA16(x0, yP0, ((f32x4){0.f, 0.f, 0.f, 0.f}));
                if (it >= 2) o = MFMA16(x1, yP1, o);
                u32x2 ow; ow.x = pk2(o[0], o[1]); ow.y = pk2(o[2], o[3]); *(u32x2*)(og + 16 * m) = ow;
                if (it == 2) *(bf16x8*)(vg + (m * 2) * 512) = x0;
                if (it == 3) *(bf16x8*)(vg + (m * 2 + 1) * 512) = x1; }
        }
    }
}

__device__ __forceinline__ void glaChain_task(const Params& p, LAS unsigned char* lds, int b, int h) {
    int tid_ = threadIdx.x; asm volatile("" : "+v"(tid_)); const int tid = tid_, lane = tid & 63, w = __builtin_amdgcn_readfirstlane(tid >> 6), fr = lane & 15, fq = lane >> 4;
    LAS unsigned char* STb = lds;
    LAS float* ssq = (LAS float*)(lds + 79872);
    const bf16_t* QHg = (const bf16_t*)(p.ws + WS_QH); const bf16_t* KOg = (const bf16_t*)(p.ws + WS_KO); const bf16_t* VTg = (const bf16_t*)(p.ws + WS_VT);
    const bf16_t* OIg = (const bf16_t*)(p.ws + WS_OI); const bf16_t* GFg = (const bf16_t*)(p.ws + WS_GF); const float* GXg = (const float*)(p.ws + WS_GX);
    bf16_t* BRANCH = (bf16_t*)(p.ws + WS_BRANCH);
    const int row0 = b * SEQ, bh = b * 4 + h;
    const int it = w & 3, eh = w >> 2;
    const int dtS0 = 3 * (w & 1), etS0 = 3 * (w >> 1);
    __syncthreads();
    for (int i = tid; i < 39936 / 4; i += NTHREADS) ((LAS unsigned*)STb)[i] = 0u;
    f32x4 S[3][3];
#pragma unroll
    for (int a = 0; a < 3; ++a)
#pragma unroll
        for (int e = 0; e < 3; ++e) S[a][e] = (f32x4){0.f, 0.f, 0.f, 0.f};
    const bf16_t* qhp = QHg + (size_t)(row0 + 16 * it + fr) * 384 + h * 96 + 8 * fq;
    const bf16_t* kop = KOg + ((size_t)bh * 32 * 12 + dtS0 * 2) * 512 + lane * 8;
    const bf16_t* vtp = VTg + ((size_t)bh * 32 * 24 + etS0 * 2) * 512 + lane * 8;
    const float* gxp = GXg + (size_t)bh * 32 * 96 + 16 * dtS0 + 4 * fq;
    const size_t oofs = (size_t)(row0 + 16 * it + fr) * 768 + h * 192 + 96 * eh + 4 * fq;
    bf16_t* outp = BRANCH + (size_t)(row0 + 16 * it + fr) * DM + 768 + h * 192 + 96 * eh + 4 * fq;
    bf16x8 bQ[3], aK[3][2], bV[3][2]; f32x4 g4[3]; u32x2 oi[6], gf[6];
#define CH_LOAD(cc) do { _Pragma("unroll") for (int ks = 0; ks < 3; ++ks) bQ[ks] = *(const bf16x8*)(qhp + (size_t)(cc) * 64 * 384 + 32 * ks); \
        _Pragma("unroll") for (int a = 0; a < 3; ++a) { _Pragma("unroll") for (int ks = 0; ks < 2; ++ks) { aK[a][ks] = *(const bf16x8*)(kop + ((size_t)(cc) * 12 + a * 2 + ks) * 512); bV[a][ks] = *(const bf16x8*)(vtp + ((size_t)(cc) * 24 + a * 2 + ks) * 512); } \
            g4[a] = *(const f32x4*)(gxp + (size_t)(cc) * 96 + 16 * a); } \
        _Pragma("unroll") for (int m = 0; m < 6; ++m) oi[m] = *(const u32x2*)(OIg + oofs + (size_t)(cc) * 64 * 768 + 16 * m); } while (0)
#define CH_LOAD_GF(cc) do { _Pragma("unroll") for (int m = 0; m < 6; ++m) gf[m] = *(const u32x2*)(GFg + oofs + (size_t)(cc) * 64 * 768 + 16 * m); } while (0)
    CH_LOAD(0); CH_LOAD_GF(0);
    __syncthreads();
#pragma unroll 1
    for (int c = 0; c < 32; ++c) {
        const int cn = c < 31 ? c + 1 : 31, cur = c & 1;
        const LAS unsigned char* stc = STb + cur * 39936; LAS unsigned char* stn = STb + (cur ^ 1) * 39936; LAS float* sq = ssq + cur * 128;
        f32x4 oacc[6];
#pragma unroll
        for (int m = 0; m < 6; ++m) { f32x4 o; o[0] = bflo(oi[m].x); o[1] = bfhi(oi[m].x); o[2] = bflo(oi[m].y); o[3] = bfhi(oi[m].y);
            const LAS unsigned char* sr = stc + (96 * eh + 16 * m + fr) * 208 + 16 * fq;
#pragma unroll
            for (int ks = 0; ks < 3; ++ks) o = MFMA16(*(const LAS bf16x8*)(sr + 64 * ks), bQ[ks], o);
            oacc[m] = o; }
        float ss = 0.f;
#pragma unroll
        for (int m = 0; m < 6; ++m) ss += (oacc[m][0] * oacc[m][0] + oacc[m][1] * oacc[m][1]) + (oacc[m][2] * oacc[m][2] + oacc[m][3] * oacc[m][3]);
        ss += __shfl_xor(ss, 16); ss += __shfl_xor(ss, 32);
        if (fq == 0) sq[(16 * it + fr) * 2 + eh] = ss;
#pragma unroll
        for (int a = 0; a < 3; ++a)
#pragma unroll
            for (int e = 0; e < 3; ++e) { f32x4 s_ = S[a][e] * g4[a]; s_ = MFMA16(aK[a][0], bV[e][0], s_); s_ = MFMA16(aK[a][1], bV[e][1], s_); S[a][e] = s_;
                u32x2 ws_; ws_.x = pk2(s_[0], s_[1]); ws_.y = pk2(s_[2], s_[3]); *(LAS u32x2*)(stn + (16 * (etS0 + e) + fr) * 208 + (16 * (dtS0 + a) + 4 * fq) * 2) = ws_; }
        CH_LOAD(cn);
        LBAR();
        {
            const f32x2 sp = *(const LAS f32x2*)(sq + 2 * (16 * it + fr));
            const float rstd = 1.0f / sqrtf((sp.x + sp.y) * (1.0f / 192.0f) + EPS);
#pragma unroll
            for (int m = 0; m < 6; ++m) { u32x2 wo; wo.x = pk2(oacc[m][0] * rstd * bflo(gf[m].x), oacc[m][1] * rstd * bfhi(gf[m].x)); wo.y = pk2(oacc[m][2] * rstd * bflo(gf[m].y), oacc[m][3] * rstd * bfhi(gf[m].y));
                *(u32x2*)(outp + (size_t)c * 64 * DM + 16 * m) = wo; }
            CH_LOAD_GF(cn);
        }
    }
    float* so = p.out + O_SP + (size_t)bh * 96 * 192;
#pragma unroll
    for (int a = 0; a < 3; ++a)
#pragma unroll
        for (int e = 0; e < 3; ++e)
#pragma unroll
            for (int j = 0; j < 4; ++j) so[(size_t)(16 * (dtS0 + a) + 4 * fq + j) * 192 + 16 * (etS0 + e) + fr] = S[a][e][j];
#undef CH_LOAD
#undef CH_LOAD_GF
}

__device__ __forceinline__ void phase_mixA(const Params& p, LAS unsigned char* lds) {
    const int G = gridDim.x, c = blockIdx.x;
    const int NGP = 512, NXP = 256, NA = 256 + 32, NTASK = NGP + NXP + NA;
    for (int t = c; t < NTASK; t += G) {
        int r = t;
        if (r < NGP) { glaPrep_task(p, lds, (r >> 2) & 3, r & 3, r >> 4); continue; }
        r -= NGP;
        if (r < NXP) { const int qt = r & 15, h = (r >> 4) & 3, b = r >> 6; mixXp_task(p, lds, b, h, qt); continue; }
        r -= NXP;
        { const int h = r & 3, blk = r >> 2; const bool smp = r >= 256; mixA2_task(p, lds, smp ? NP + (blk - 64) * 128 : blk * 128, h, smp ? 8 : 128, smp); }
    }
}
__device__ __forceinline__ void phase_mixB(const Params& p, LAS unsigned char* lds) {
    const int G = gridDim.x, c = blockIdx.x;
    if (c < 16 && G > 16) { glaChain_task(p, lds, c >> 2, c & 3); return; }
    const int NXS = 512, NBS = 512, NTASK = NXS + NBS;
    for (int t = (G > 16 ? c - 16 : c); t < NTASK; t += (G > 16 ? G - 16 : G)) {
        int r = t;
        if (r < NXS) { const int h = r & 3, b = r >> 2; mixXs_task(p, lds, b, h); continue; }
        r -= NXS;
        { const int b = r >> 2, h = r & 3; mixB_task(p, lds, NP + b * 8, 8, h, p.state + (size_t)(b * 4 + h) * 96 * 192, p.out + O_SS + (size_t)(b * 4 + h) * 96 * 192); }
    }
}

__device__ __forceinline__ void phase_final(const Params& p) {
    const int lane = threadIdx.x & 63, wave = threadIdx.x >> 6;
    const int gw = blockIdx.x * 8 + wave, NGW = gridDim.x * 8;
    for (int r = gw; r < NTOK; r += NGW) {
        f32x4* s = (f32x4*)(p.out + (size_t)r * DM) + lane; const f32x4* wv = (const f32x4*)p.final_w + lane;
        f32x4 v[8]; float ss = 0.f;
#pragma unroll
        for (int j = 0; j < 8; ++j) { v[j] = s[64 * j]; ss += (v[j].x * v[j].x + v[j].y * v[j].y) + (v[j].z * v[j].z + v[j].w * v[j].w); }
        const float rstd = 1.0f / sqrtf(wave_sum(ss) * (1.0f / DM) + EPS);
#pragma unroll
        for (int j = 0; j < 8; ++j) { const f32x4 ww = wv[64 * j]; s[64 * j] = v[j] * rstd * ww; }
    }
}


#define XB_TMO      128
#define XB_XCNT(j)  (256  + 64 * (j))
#define XB_XSUB(j)  (1280 + 64 * (j))
#define XB_XGEN(j)  (2304 + 64 * (j))
#define XB_TOP      3328
#define XB_TOPGEN   3392
#define XCD_BAR_WORDS 3456
#define XB_SPIN_CAP (1u << 18)
__device__ __forceinline__ unsigned xb_ld(unsigned* p)              { return __hip_atomic_load(p, __ATOMIC_RELAXED, __HIP_MEMORY_SCOPE_AGENT); }
__device__ __forceinline__ unsigned xb_add(unsigned* p, unsigned v) { return __hip_atomic_fetch_add(p, v, __ATOMIC_RELAXED, __HIP_MEMORY_SCOPE_AGENT); }
__device__ __forceinline__ unsigned xb_xcc_id() { return (unsigned)__builtin_amdgcn_s_getreg((3 << 11) | 20) & 0xFu; }
#define XB_SPIN(cond, bar) do { unsigned _sp = 0; while (cond) { __builtin_amdgcn_s_sleep(1); \
    if ((++_sp & 255u) == 0u) { if (xb_ld(&(bar)[XB_TMO])) break; if (_sp > XB_SPIN_CAP) { atomicAdd(&(bar)[XB_TMO], 1u); break; } } } } while (0)
struct XcdBarrier { unsigned* bar; unsigned x; volatile LAS unsigned* st; };
__device__ __forceinline__ XcdBarrier xcd_barrier_post(unsigned* bar, volatile LAS unsigned* st) {
    XcdBarrier b; b.bar = bar; b.x = xb_xcc_id(); b.st = st;
    if (threadIdx.x == 0) (void)xb_add(&bar[XB_XCNT(b.x)], 1u);
    return b;
}
__device__ __forceinline__ void xcd_barrier_complete(unsigned* bar, unsigned x, unsigned& nloc, unsigned& nx) {
    const unsigned G = gridDim.x * gridDim.y * gridDim.z;
    unsigned sum, cnt, mine, sp = 0u;
    for (;;) {
        sum = 0u; cnt = 0u; mine = 0u;
#pragma unroll
        for (unsigned j = 0; j < 16; ++j) { const unsigned c = xb_ld(&bar[XB_XCNT(j)]); sum += c; cnt += (c > 0u) ? 1u : 0u; mine = (j == x) ? c : mine; }
        if (sum == G) break;
        __builtin_amdgcn_s_sleep(1);
        if ((++sp & 255u) == 0u) { if (xb_ld(&bar[XB_TMO])) break; if (sp > XB_SPIN_CAP) { atomicAdd(&bar[XB_TMO], 1u); break; } }
    }
    nloc = mine > 0u ? mine : 1u; nx = cnt > 0u ? cnt : 1u;
}
__device__ __forceinline__ void xcd_barrier(const XcdBarrier& b) {
    asm volatile("s_waitcnt vmcnt(0)" ::: "memory");
    __syncthreads();
    if (threadIdx.x == 0) {
        unsigned* bar = b.bar;
        __builtin_amdgcn_s_waitcnt(0);
        unsigned nloc = b.st[0], nx = b.st[1];
        if (nloc == 0u) { xcd_barrier_complete(bar, b.x, nloc, nx); b.st[0] = nloc; b.st[1] = nx; }
        const unsigned old = xb_add(&bar[XB_XSUB(b.x)], 1u);
        const unsigned gen = old / nloc;
        if (old + 1u == (gen + 1u) * nloc) {
            __builtin_amdgcn_fence(__ATOMIC_RELEASE, "agent");
            asm volatile("s_waitcnt vmcnt(0)" ::: "memory");
            const unsigned og = xb_add(&bar[XB_TOP], 1u);
            const unsigned tg = og / nx;
            if (og + 1u == (tg + 1u) * nx) xb_add(&bar[XB_TOPGEN], 1u);
            else XB_SPIN(xb_ld(&bar[XB_TOPGEN]) == tg, bar);
            __builtin_amdgcn_fence(__ATOMIC_ACQUIRE, "agent");
            xb_add(&bar[XB_XGEN(b.x)], 1u);
            asm volatile("s_waitcnt vmcnt(0)" ::: "memory");
        } else {
            XB_SPIN(xb_ld(&bar[XB_XGEN(b.x)]) == gen, bar);
            __builtin_amdgcn_fence(__ATOMIC_ACQUIRE, "agent");
            asm volatile("s_waitcnt vmcnt(0)" ::: "memory");
        }
    }
    __syncthreads();
}

__global__ void __launch_bounds__(NTHREADS, 2) fwd(Params p) {
    extern __shared__ __attribute__((aligned(16))) unsigned char lds_raw[];
    LAS unsigned char* lds = (LAS unsigned char*)lds_raw;
    const int lo = p.ph_lo, hi = p.ph_hi;
    volatile LAS unsigned* MISC = (volatile LAS unsigned*)(lds + LDS_MISC);
    if (threadIdx.x < 64) MISC[threadIdx.x] = 0u;
    __syncthreads();
    XcdBarrier bar; bar.bar = (unsigned*)(p.ws + WS_CTL) + 4096; bar.x = 0; bar.st = nullptr;
    if (hi - lo > 1) bar = xcd_barrier_post((unsigned*)(p.ws + WS_CTL) + 4096, MISC + 8);
#define BOTH(k) (IN(k) && IN((k) + 1))
#ifndef PH_MASK
#define PH_MASK 63
#endif
#define IN(k) (((PH_MASK >> (k)) & 1) && lo <= (k) && (k) < hi)
    if (IN(0)) { phase_prep(p, lds); if (BOTH(0)) xcd_barrier(bar); }
    if (IN(1)) {
        Prog1 P; P.XB = (const char*)(p.ws + WS_XB); P.WIN = (const char*)(p.ws + WS_WIN); P.MB = (const char*)(p.ws + WS_MB); P.WM = (const char*)(p.ws + WS_WM);
        P.PROJ = (bf16_t*)(p.ws + WS_PROJ); P.out = p.out; P.MKB = (bf16_t*)(p.ws + WS_MKB); P.MVB = (bf16_t*)(p.ws + WS_MVB); P.G = gridDim.x; P.c = blockIdx.x;
        pg8::gemm_phase(lds, P);
        const int wave = threadIdx.x >> 6, lane = threadIdx.x & 63;
        for (int t = (blockIdx.x + gridDim.x - 40) % gridDim.x; t < 72; t += gridDim.x) br_task((const bf16_t*)(p.ws + WS_XB), (const bf16_t*)(p.ws + WS_WR), (float*)(p.ws + WS_BR), t, wave, lane);
        if (BOTH(1)) xcd_barrier(bar);
    }
    if (IN(2)) { phase_mixA(p, lds); if (BOTH(2)) xcd_barrier(bar); }
    if (IN(3)) { phase_mixB(p, lds); if (BOTH(3)) xcd_barrier(bar); }
    if (IN(4)) {
        Prog3 P; P.BRANCH = (const char*)(p.ws + WS_BRANCH); P.WO = (const char*)(p.ws + WS_WO); P.xp = p.x_prompt; P.xs = p.x_sample; P.out = p.out; P.G = gridDim.x; P.c = blockIdx.x;
        pg8::gemm_phase(lds, P);
        if (BOTH(4)) xcd_barrier(bar);
    }
    if (IN(5)) phase_final(p);
#undef IN
#undef BOTH
}

extern "C" void kernel_launch(void* const* d_in, const int* in_sizes, int n_in, void* d_out, int out_size, void* d_ws, size_t ws_size, hipStream_t stream) {
    static int grid = 0;
    if (grid == 0) {
        if (n_in != 18 || ws_size < WS_END) { fprintf(stderr, "kernel_launch: unexpected n_in %d or ws_size %zu\n", n_in, ws_size); grid = -1; return; }
        int dev = 0, cus = 0;
        if (hipGetDevice(&dev) != hipSuccess || hipDeviceGetAttribute(&cus, hipDeviceAttributeMultiprocessorCount, dev) != hipSuccess) { grid = -1; return; }
        if (hipFuncSetAttribute((const void*)fwd, hipFuncAttributeMaxDynamicSharedMemorySize, LDS_BYTES) != hipSuccess) { fprintf(stderr, "kernel_launch: hipFuncSetAttribute failed\n"); grid = -1; return; }
        grid = cus > 0 ? cus : 256;
    }
    if (grid < 0) return;
    Params p{};
    const float** pp = (const float**)&p;
    for (int i = 0; i < 18; ++i) pp[i] = (const float*)d_in[i];
    p.out = (float*)d_out; p.ws = (unsigned char*)d_ws;
    (void)hipMemsetAsync((char*)d_ws + WS_CTL, 0, 65536, stream);
#if N_LAUNCH_MODE == 1
    p.ph_lo = 0; p.ph_hi = 6; hipLaunchKernelGGL(fwd, dim3(grid), dim3(NTHREADS), LDS_BYTES, stream, p);
#else
    for (int ph = 0; ph < 6; ++ph) { p.ph_lo = ph; p.ph_hi = ph + 1; hipLaunchKernelGGL(fwd, dim3(grid), dim3(NTHREADS), LDS_BYTES, stream, p); }
#endif
}
```

```cpp
#include <hip/hip_runtime.h>
#include <cstdio>
#include <cstdint>

#define LAS __attribute__((address_space(3)))
typedef unsigned short bf16_t;
typedef short bf16x8 __attribute__((ext_vector_type(8)));
typedef float f32x4 __attribute__((ext_vector_type(4)));
typedef float f32x2 __attribute__((ext_vector_type(2)));
typedef unsigned u32x4 __attribute__((ext_vector_type(4)));
typedef unsigned u32x2 __attribute__((ext_vector_type(2)));

#define USE_A2 1
#define USE_XP 1
#define USE_XS 1
#ifndef N_LAUNCH_MODE
#define N_LAUNCH_MODE 1
#endif

constexpr int DM = 2048;
constexpr int NP = 8192, NS = 1024, NTOK = NP + NS, NMR = 1024;
constexpr int SEQ = 2048, DSEQ = 8, NB = 4, DB = 128, NMEM = 256;
constexpr int DIN = 5648, DINP = 5632;
constexpr int C_AU = 0, C_AV = 768, C_AG = 1536, C_BQ = 2304, C_BK = 2688, C_BV = 3072, C_BG = 3840, C_XQ = 4608, C_XG = 5120;
constexpr int SRC_BR = 3840;
constexpr float EPS = 1e-6f;
constexpr size_t O_Y = 0, O_MK = 18874368, O_MV = 19398656, O_SP = 19922944, O_SS = 20217856, O_CV = 29655040;
constexpr size_t MiB = 1u << 20;
constexpr size_t WS_CTL = 0, CTL_BYTES = 1 * MiB;
constexpr size_t WS_XB = 2 * MiB, WS_MB = 38 * MiB, WS_WIN = 42 * MiB, WS_WM = 64 * MiB, WS_WO = 68 * MiB, WS_WR = 76 * MiB, WS_BR = 77 * MiB,
                 WS_MKB = 78 * MiB, WS_MVB = 79 * MiB, WS_PROJ = 80 * MiB, WS_BRANCH = 180 * MiB, WS_END = 252 * MiB;
constexpr size_t WS_QH = 2 * MiB, WS_ST = 9 * MiB, WS_OI = 29 * MiB, WS_GF = 42 * MiB, WS_GX = 55 * MiB, WS_H = 216 * MiB;
constexpr int LDS_MISC = 147456;
constexpr int LDS_BYTES = 148480;
constexpr int NTHREADS = 512;

struct Params {
    const float *x_prompt, *x_sample, *mem, *state, *cache_k, *cache_v, *norm_w, *w_in, *a_vnorm_w, *a_ws, *a_bs, *b_wa, *b_ba, *b_onorm_w,
                *mem_norm_w, *w_mem, *w_out, *final_w;
    float* out; unsigned char* ws;
    int ph_lo, ph_hi;
};

typedef __bf16 bf16x2_t __attribute__((ext_vector_type(2)));
__device__ __forceinline__ unsigned cvt_pk_bf16(float lo, float hi) { const f32x2 v = {lo, hi}; const bf16x2_t b = __builtin_convertvector(v, bf16x2_t); return __builtin_bit_cast(unsigned, b); }
__device__ __forceinline__ unsigned pk2(float lo, float hi) { return cvt_pk_bf16(lo, hi); }
__device__ __forceinline__ unsigned f2bf(float f) { return cvt_pk_bf16(f, 0.f) & 0xffffu; }
__device__ __forceinline__ float bflo(unsigned w) { return __builtin_bit_cast(float, w << 16); }
__device__ __forceinline__ float bfhi(unsigned w) { return __builtin_bit_cast(float, w & 0xffff0000u); }
__device__ __forceinline__ float bf2f(bf16_t b) { return __builtin_bit_cast(float, ((unsigned)b) << 16); }
__device__ __forceinline__ float wave_sum(float v) {
#pragma unroll
    for (int o = 1; o < 64; o <<= 1) v += __shfl_xor(v, o);
    return v;
}
__device__ __forceinline__ float wave_max(float v) {
#pragma unroll
    for (int o = 1; o < 64; o <<= 1) v = fmaxf(v, __shfl_xor(v, o));
    return v;
}
__device__ __forceinline__ float silu(float x) { return x * __builtin_amdgcn_rcpf(1.0f + __expf(-x)); }


typedef short s16x4 __attribute__((ext_vector_type(4)));
__device__ __forceinline__ s16x4 tr_read(unsigned addr) { s16x4 r; asm volatile("ds_read_b64_tr_b16 %0, %1" : "=&v"(r) : "v"(addr) : "memory"); return r; }
#define TR_WAIT() do { asm volatile("s_waitcnt lgkmcnt(0)" ::: "memory"); __builtin_amdgcn_sched_barrier(0); } while (0)
#define PK8(L, H) ((bf16x8){(L)[0], (L)[1], (L)[2], (L)[3], (H)[0], (H)[1], (H)[2], (H)[3]})
#define LBAR() do { asm volatile("s_waitcnt lgkmcnt(0)" ::: "memory"); __builtin_amdgcn_s_barrier(); asm volatile("" ::: "memory"); } while (0)
#define MFMA16(a, b, c) __builtin_amdgcn_mfma_f32_16x16x32_bf16((a), (b), (c), 0, 0, 0)

namespace pg8 {
constexpr int BM = 256, BK = 64, HALF = 128, HTB = HALF * BK * 2, STAGE_BYTES = 8 * HTB, NXCD = 8, WGM = 8;
constexpr int K = DM, NT = K / BK;
constexpr size_t TSTEP = (size_t)BM * K * 2;
__device__ __forceinline__ int lds_byte(int r, int c) { const int st = (r >> 4) * 2 + (c >> 5), rr = r & 15, cc = c & 31, ob = rr * 64 + cc * 2; return st * 1024 + (ob ^ (((ob >> 9) & 1) << 5)); }
__device__ __forceinline__ void stage_rc(int b, int& R, int& C) { const int st = b / 1024, sb = b % 1024, swz = sb ^ (((sb >> 9) & 1) << 5); R = (st >> 1) * 16 + swz / 64; C = (st & 1) * 32 + (swz % 64) / 2; }
__device__ __forceinline__ int perm32(int rho) { const int n = rho >> 4, i = rho & 15; return 8 * (i >> 2) + 4 * n + (i & 3); }
struct Unit { int pm, pn, kind; };
__device__ __forceinline__ void static_tile(int L, int nM, int nN, int& pm, int& pn) {
    const int nwg = nM * nN; int wgid = L; { const int q = nwg / NXCD, r = nwg % NXCD, xcd = wgid % NXCD, off = wgid / NXCD; wgid = (xcd < r ? xcd * (q + 1) : r * (q + 1) + (xcd - r) * q) + off; }
    const int nig = WGM * nN, gid = wgid / nig, fm = gid * WGM, gsz = (nM - fm) < WGM ? (nM - fm) : WGM;
    pm = fm + ((wgid % nig) % gsz); pn = (wgid % nig) / gsz;
}
typedef f32x4 Acc[2][2][4][2];

template <class Prog>
__device__ __forceinline__ void gemm_phase(LAS unsigned char* lds, const Prog& P) {
    const int tid = threadIdx.x, wid = __builtin_amdgcn_readfirstlane(tid >> 6), lane = tid & 63, wr = wid >> 2, wc = wid & 3, fr = lane & 15, fq = lane >> 4;
    unsigned voffA[2], voffB[2];
#pragma unroll
    for (int i = 0; i < 2; ++i) { int R, C; stage_rc(tid * 16 + i * 8192, R, C); const int Rb = (R & ~31) + perm32(R & 31);
        voffA[i] = (unsigned)(R * K + C) * 2u; voffB[i] = (unsigned)(Rb * K + C) * 2u; }
    const size_t kstep = (size_t)(BK * 2);
    const size_t hstep = (size_t)HALF * K * 2;
    const unsigned ldsw = (unsigned)wid * 1024u;
    const int aoff = lds_byte(wr * 64 + fr, fq * 8), boff = lds_byte(wc * 32 + fr, fq * 8);
#define PG8_SA(b, h) (((b) * 2 + (h)) * HTB)
#define PG8_SB(b, h) ((4 + (b) * 2 + (h)) * HTB)
#define PG8_STAGE(bufoff, gbase, voff) do { _Pragma("unroll") for (int _i = 0; _i < 2; ++_i) \
        __builtin_amdgcn_global_load_lds((const unsigned*)((const char*)(gbase) + (voff)[_i]), (LAS unsigned*)(lds + (bufoff) + ldsw + _i * 8192), 16, 0, 0); } while (0)
#define PG8_LDA(dst, b, h) do { _Pragma("unroll") for (int m = 0; m < 4; ++m) _Pragma("unroll") for (int k = 0; k < 2; ++k) dst[m][k] = *(const LAS bf16x8*)(lds + PG8_SA(b, h) + aoff + m * 2048 + k * 1024); } while (0)
#define PG8_LDB(dst, b, h) do { _Pragma("unroll") for (int n = 0; n < 2; ++n) _Pragma("unroll") for (int k = 0; k < 2; ++k) dst[n][k] = *(const LAS bf16x8*)(lds + PG8_SB(b, h) + boff + n * 2048 + k * 1024); } while (0)
#define PG8_MMA(ai, bj, At, Bt) do { __builtin_amdgcn_s_setprio(1); _Pragma("unroll") for (int m = 0; m < 4; ++m) _Pragma("unroll") for (int n = 0; n < 2; ++n) _Pragma("unroll") for (int k = 0; k < 2; ++k) \
        acc[ai][bj][m][n] = __builtin_amdgcn_mfma_f32_16x16x32_bf16(Bt[n][k], At[m][k], acc[ai][bj][m][n], 0, 0, 0); __builtin_amdgcn_s_setprio(0); } while (0)
#define PG8_WAIT_V(n) asm volatile("s_waitcnt vmcnt(" #n ")" ::: "memory")
#define PG8_WAIT_L(n) asm volatile("s_waitcnt lgkmcnt(" #n ")" ::: "memory")
#define PG8_BAR __builtin_amdgcn_s_barrier()
#define PG8_SCHED __builtin_amdgcn_sched_barrier(0)
    Unit cur, nxt; int ui = 0;
    if (!P.next(0, cur)) return;
    Acc acc;
#pragma unroll
    for (int a = 0; a < 2; ++a)
#pragma unroll
        for (int b = 0; b < 2; ++b)
#pragma unroll
            for (int m = 0; m < 4; ++m)
#pragma unroll
                for (int n = 0; n < 2; ++n) acc[a][b][m][n] = (f32x4){0.f, 0.f, 0.f, 0.f};
    bf16x8 At[4][2], B0[2][2], B1[2][2];
    const char* cA = P.a_ptr(cur); const char* cB = P.b_ptr(cur);
    PG8_STAGE(PG8_SB(0, 0), cB, voffB); PG8_STAGE(PG8_SA(0, 0), cA, voffA); PG8_STAGE(PG8_SB(0, 1), cB + hstep, voffB); PG8_STAGE(PG8_SA(0, 1), cA + hstep, voffA);
    if (wr == 1) PG8_BAR;
    PG8_WAIT_V(4); PG8_BAR;
    PG8_STAGE(PG8_SB(1, 0), cB + kstep, voffB); PG8_STAGE(PG8_SA(1, 0), cA + kstep, voffA); PG8_STAGE(PG8_SB(1, 1), cB + hstep + kstep, voffB);
    PG8_WAIT_V(6); PG8_BAR;
    for (;;) {
        const bool has_next = P.next(ui + 1, nxt);
        const char* nA = has_next ? P.a_ptr(nxt) : cA; const char* nB = has_next ? P.b_ptr(nxt) : cB;
        for (int t = 0; t < NT; t += 2) {
            const bool last = (t == NT - 2);
            const char* a1 = cA + (size_t)(t + 1) * kstep;
            const char* a2 = last ? nA : cA + (size_t)(t + 2) * kstep; const char* b2 = last ? nB : cB + (size_t)(t + 2) * kstep;
            const char* a3 = a2 + kstep; const char* b3 = b2 + kstep;
            PG8_LDB(B0, 0, 0); PG8_SCHED; PG8_LDA(At, 0, 0); PG8_STAGE(PG8_SA(1, 1), a1 + hstep, voffA);
            PG8_WAIT_L(8); PG8_BAR; PG8_WAIT_L(0); PG8_MMA(0, 0, At, B0); PG8_BAR; PG8_SCHED;
            PG8_LDB(B1, 0, 1); PG8_STAGE(PG8_SB(0, 0), b2, voffB);
            PG8_BAR; PG8_WAIT_L(0); PG8_MMA(0, 1, At, B1); PG8_BAR;
            PG8_LDA(At, 0, 1); PG8_STAGE(PG8_SA(0, 0), a2, voffA);
            PG8_BAR; PG8_WAIT_L(0); PG8_MMA(1, 0, At, B0); PG8_BAR; PG8_SCHED;
            PG8_STAGE(PG8_SB(0, 1), b2 + hstep, voffB);
            PG8_WAIT_V(6); PG8_BAR; PG8_MMA(1, 1, At, B1); PG8_BAR;
            PG8_LDB(B0, 1, 0); PG8_SCHED; PG8_LDA(At, 1, 0); PG8_STAGE(PG8_SA(0, 1), a2 + hstep, voffA);
            PG8_WAIT_L(8); PG8_BAR; PG8_WAIT_L(0); PG8_MMA(0, 0, At, B0); PG8_BAR; PG8_SCHED;
            PG8_LDB(B1, 1, 1); PG8_STAGE(PG8_SB(1, 0), b3, voffB);
            PG8_BAR; PG8_WAIT_L(0); PG8_MMA(0, 1, At, B1); PG8_BAR;
            PG8_LDA(At, 1, 1); PG8_STAGE(PG8_SA(1, 0), a3, voffA);
            PG8_BAR; PG8_WAIT_L(0); PG8_MMA(1, 0, At, B0); PG8_BAR; PG8_SCHED;
            PG8_STAGE(PG8_SB(1, 1), b3 + hstep, voffB);
            PG8_WAIT_V(6); PG8_BAR; PG8_MMA(1, 1, At, B1); PG8_BAR;
        }
        P.epi(acc, cur, wr, wc, fr, fq);
        if (!has_next) break;
#pragma unroll
        for (int a = 0; a < 2; ++a)
#pragma unroll
            for (int b = 0; b < 2; ++b)
#pragma unroll
                for (int m = 0; m < 4; ++m)
#pragma unroll
                    for (int n = 0; n < 2; ++n) acc[a][b][m][n] = (f32x4){0.f, 0.f, 0.f, 0.f};
        cur = nxt; cA = nA; cB = nB; ++ui;
    }
    PG8_WAIT_V(0);
    if (wr == 0) PG8_BAR;
    PG8_BAR;
#undef PG8_SA
#undef PG8_SB
#undef PG8_STAGE
#undef PG8_LDA
#undef PG8_LDB
#undef PG8_MMA
#undef PG8_WAIT_V
#undef PG8_WAIT_L
#undef PG8_BAR
#undef PG8_SCHED
}
}

struct Prog1 {
    const char *XB, *WIN, *MB, *WM; bf16_t* PROJ; float* out; bf16_t *MKB, *MVB; int G, c;
    __device__ __forceinline__ bool next(int i, pg8::Unit& u) const {
        const int L = i * G + c; if (L >= 808) return false;
        if (L < 792) { pg8::static_tile(L, 36, 22, u.pm, u.pn); u.kind = 0; } else { const int r = L - 792; u.pm = r >> 2; u.pn = r & 3; u.kind = 1; }
        return true;
    }
    __device__ __forceinline__ const char* a_ptr(const pg8::Unit& u) const { return (u.kind == 0 ? XB : MB) + (size_t)u.pm * pg8::TSTEP; }
    __device__ __forceinline__ const char* b_ptr(const pg8::Unit& u) const { return (u.kind == 0 ? WIN : WM) + (size_t)u.pn * pg8::TSTEP; }
    __device__ __forceinline__ void epi(const pg8::Acc& acc, const pg8::Unit& u, int wr, int wc, int fr, int fq) const {
        const int row0 = u.pm * 256 + wr * 64 + fr;
        if (u.kind == 0) {
            const int col0 = u.pn * 256 + wc * 32 + 8 * fq;
#pragma unroll
            for (int ai = 0; ai < 2; ++ai)
#pragma unroll
                for (int m = 0; m < 4; ++m) { bf16_t* rowp = PROJ + (size_t)(row0 + ai * 128 + m * 16) * DINP + col0;
#pragma unroll
                    for (int bj = 0; bj < 2; ++bj) { const f32x4 v0 = acc[ai][bj][m][0], v1 = acc[ai][bj][m][1];
                        u32x4 w; w.x = cvt_pk_bf16(v0[0], v0[1]); w.y = cvt_pk_bf16(v0[2], v0[3]); w.z = cvt_pk_bf16(v1[0], v1[1]); w.w = cvt_pk_bf16(v1[2], v1[3]);
                        *(u32x4*)(rowp + bj * 128) = w; } }
        } else {
            const int col0 = (u.pn & 1) * 256 + wc * 32 + 8 * fq;
            float* dst = out + (u.pn < 2 ? O_MK : O_MV); bf16_t* dstb = (u.pn < 2 ? MKB : MVB);
#pragma unroll
            for (int ai = 0; ai < 2; ++ai)
#pragma unroll
                for (int m = 0; m < 4; ++m) { const size_t off = (size_t)(row0 + ai * 128 + m * 16) * 512 + col0;
#pragma unroll
                    for (int bj = 0; bj < 2; ++bj) { const f32x4 v0 = acc[ai][bj][m][0], v1 = acc[ai][bj][m][1];
                        *(f32x4*)(dst + off + bj * 128) = v0; *(f32x4*)(dst + off + bj * 128 + 4) = v1;
                        u32x4 w; w.x = cvt_pk_bf16(v0[0], v0[1]); w.y = cvt_pk_bf16(v0[2], v0[3]); w.z = cvt_pk_bf16(v1[0], v1[1]); w.w = cvt_pk_bf16(v1[2], v1[3]);
                        *(u32x4*)(dstb + off + bj * 128) = w; } }
        }
    }
};
struct Prog3 {
    const char *BRANCH, *WO; const float *xp, *xs; float* out; int G, c;
    __device__ __forceinline__ bool next(int i, pg8::Unit& u) const {
        const int L = i * G + c; if (L >= 288) return false;
        pg8::static_tile(L, 36, 8, u.pm, u.pn); u.kind = 2; return true;
    }
    __device__ __forceinline__ const char* a_ptr(const pg8::Unit& u) const { return BRANCH + (size_t)u.pm * pg8::TSTEP; }
    __device__ __forceinline__ const char* b_ptr(const pg8::Unit& u) const { return WO + (size_t)u.pn * pg8::TSTEP; }
    __device__ __forceinline__ void epi(const pg8::Acc& acc, const pg8::Unit& u, int wr, int wc, int fr, int fq) const {
        const int row0 = u.pm * 256 + wr * 64 + fr; const int col0 = u.pn * 256 + wc * 32 + 8 * fq;
        const float* xb = (u.pm < 32) ? xp : (xs - (size_t)NP * DM);
#pragma unroll
        for (int ai = 0; ai < 2; ++ai)
#pragma unroll
            for (int m = 0; m < 4; ++m) { const size_t off = (size_t)(row0 + ai * 128 + m * 16) * DM + col0;
#pragma unroll
                for (int bj = 0; bj < 2; ++bj) { const f32x4 x0 = *(const f32x4*)(xb + off + bj * 128), x1 = *(const f32x4*)(xb + off + bj * 128 + 4);
                    *(f32x4*)(out + off + bj * 128) = acc[ai][bj][m][0] + x0; *(f32x4*)(out + off + bj * 128 + 4) = acc[ai][bj][m][1] + x1; } }
    }
};

__device__ __forceinline__ void norm_row_to_bf16(const float* src, const float* w, bf16_t* dst, int lane) {
    const f32x4* s = (const f32x4*)src + lane; const f32x4* wv = (const f32x4*)w + lane;
    f32x4 v[8]; float ss = 0.f;
#pragma unroll
    for (int j = 0; j < 8; ++j) { v[j] = s[64 * j]; ss += (v[j].x * v[j].x + v[j].y * v[j].y) + (v[j].z * v[j].z + v[j].w * v[j].w); }
    const float rstd = 1.0f / sqrtf(wave_sum(ss) * (1.0f / DM) + EPS);
    u32x2* o = (u32x2*)dst + lane;
#pragma unroll
    for (int j = 0; j < 8; ++j) { const f32x4 ww = wv[64 * j]; u32x2 r; r.x = pk2(v[j].x * rstd * ww.x, v[j].y * rstd * ww.y); r.y = pk2(v[j].z * rstd * ww.z, v[j].w * rstd * ww.w); o[64 * j] = r; }
}
__device__ __forceinline__ void transpose_item(const float* W, int ldw, int csrc, bf16_t* WT, int n0, int k0, LAS float* scr, int lane) {
#pragma unroll 8
    for (int i = 0; i < 32; ++i) { const int kk = 2 * i + (lane >> 5); scr[kk * 33 + (lane & 31)] = W[(size_t)(k0 + kk) * ldw + csrc + (lane & 31)]; }
    asm volatile("s_waitcnt lgkmcnt(0)" ::: "memory");
    const int c = lane & 7;
#pragma unroll
    for (int j = 0; j < 4; ++j) { const int n = (lane >> 3) + 8 * j; const LAS float* s = scr + (8 * c) * 33 + n;
        u32x4 o; o.x = pk2(s[0 * 33], s[1 * 33]); o.y = pk2(s[2 * 33], s[3 * 33]); o.z = pk2(s[4 * 33], s[5 * 33]); o.w = pk2(s[6 * 33], s[7 * 33]);
        *(u32x4*)(WT + (size_t)(n0 + n) * DM + k0 + 8 * c) = o; }
    asm volatile("s_waitcnt lgkmcnt(0)" ::: "memory");
}
__device__ __forceinline__ void phase_prep(const Params& p, LAS unsigned char* lds) {
    const int tid = threadIdx.x, lane = tid & 63, wave = tid >> 6;
    const int gw = blockIdx.x * 8 + wave, NGW = gridDim.x * 8;
    unsigned char* ws = p.ws;
    bf16_t* XB = (bf16_t*)(ws + WS_XB); bf16_t* MB = (bf16_t*)(ws + WS_MB);
    for (int r = gw; r < NTOK + NMR; r += NGW) {
        if (r < NP) norm_row_to_bf16(p.x_prompt + (size_t)r * DM, p.norm_w, XB + (size_t)r * DM, lane);
        else if (r < NTOK) norm_row_to_bf16(p.x_sample + (size_t)(r - NP) * DM, p.norm_w, XB + (size_t)r * DM, lane);
        else norm_row_to_bf16(p.mem + (size_t)(r - NTOK) * DM, p.mem_norm_w, MB + (size_t)(r - NTOK) * DM, lane);
    }
    LAS float* scr = (LAS float*)(lds + wave * 8704);
    constexpr int I_IN = 32 * (DINP / 32), I_M = 32 * (1024 / 32), I_O = 32 * (2048 / 32);
    bf16_t* WIN = (bf16_t*)(ws + WS_WIN); bf16_t* WM = (bf16_t*)(ws + WS_WM); bf16_t* WO = (bf16_t*)(ws + WS_WO); bf16_t* WR = (bf16_t*)(ws + WS_WR);
    for (int it = gw; it < I_IN + I_M + I_O; it += NGW) {
        int r = it;
        if (r < I_IN) { const int nb = r % (DINP / 32), kb = r / (DINP / 32), n0 = nb * 32; transpose_item(p.w_in, DIN, n0 + (n0 >= SRC_BR ? 16 : 0), WIN, n0, kb * 64, scr, lane); continue; }
        r -= I_IN;
        if (r < I_M) { const int nb = r % 32, kb = r / 32; transpose_item(p.w_mem, 1024, nb * 32, WM, nb * 32, kb * 64, scr, lane); continue; }
        r -= I_M;
        { const int nb = r % 64, kb = r / 64; transpose_item(p.w_out, 2048, nb * 32, WO, nb * 32, kb * 64, scr, lane); }
    }
    for (int i = blockIdx.x * NTHREADS + tid; i < 16 * DM; i += gridDim.x * NTHREADS) { const int r = i & 15, k = i >> 4; WR[r * DM + k] = (bf16_t)f2bf(p.w_in[(size_t)k * DIN + SRC_BR + r]); }
}

__device__ __forceinline__ void br_task(const bf16_t* XB, const bf16_t* WR, float* BR, int task, int wave, int lane) {
    const int fr = lane & 15, fq = lane >> 4, row0 = task * 128 + wave * 16;
    const bf16_t* ap = XB + (size_t)(row0 + fr) * DM + 8 * fq; const bf16_t* bp = WR + (size_t)fr * DM + 8 * fq;
    f32x4 acc = (f32x4){0.f, 0.f, 0.f, 0.f};
#pragma unroll 8
    for (int k0 = 0; k0 < DM; k0 += 32) { const bf16x8 a = *(const bf16x8*)(ap + k0), b = *(const bf16x8*)(bp + k0); acc = __builtin_amdgcn_mfma_f32_16x16x32_bf16(a, b, acc, 0, 0, 0); }
#pragma unroll
    for (int j = 0; j < 4; ++j) BR[(size_t)(row0 + 4 * fq + j) * 16 + fr] = acc[j];
}

__device__ __forceinline__ void mixA_task(const Params& p, LAS unsigned char* lds, int row0, int h, int L, bool write_cv) {
    int tid_ = threadIdx.x; asm volatile("" : "+v"(tid_)); const int tid = tid_, lane = tid & 63, wave = tid >> 6;
    const bf16_t* PROJ = (const bf16_t*)(p.ws + WS_PROJ); bf16_t* BRANCH = (bf16_t*)(p.ws + WS_BRANCH);
    LAS float* Wl = (LAS float*)lds;
    LAS bf16_t* vn = (LAS bf16_t*)(lds + 65536);
    LAS float* rs = (LAS float*)(lds + 65536 + 49152);
    __syncthreads();
    for (int t = wave * 16; t < wave * 16 + 16; ++t) {
        const u32x2* src = (const u32x2*)(PROJ + (size_t)(row0 + t) * DINP + C_AV) + lane; float ss = 0.f;
#pragma unroll
        for (int j = 0; j < 3; ++j) { const u32x2 w = src[64 * j]; const float a = bflo(w.x), b = bfhi(w.x), c = bflo(w.y), d = bfhi(w.y); ss += (a * a + b * b) + (c * c + d * d); }
        ss = wave_sum(ss);
        if (lane == 0) rs[t] = 1.0f / sqrtf(ss * (1.0f / 768.0f) + EPS);
    }
    for (int i = tid; i < 128 * 32; i += NTHREADS) ((LAS f32x4*)Wl)[i] = ((const f32x4*)(p.a_ws + (size_t)h * 16384))[i];
    __syncthreads();
    for (int i = tid; i < 128 * 192; i += NTHREADS) { const int t = i / 192, dd = i % 192;
        const float v = bf2f(PROJ[(size_t)(row0 + t) * DINP + C_AV + h * 192 + dd]) * rs[t] * p.a_vnorm_w[h * 192 + dd];
        vn[i] = (bf16_t)f2bf(v);
        if (write_cv) p.out[O_CV + (size_t)(row0 - NP + t) * 768 + h * 192 + dd] = v; }
    __syncthreads();
    if (tid < 384) {
        const int dd2 = tid % 96, ig = tid / 96;
        for (int k = 0; k < 32; ++k) {
            const int rl = ig + 4 * k, i = rl % L, cs = rl - i;
            float a0 = 0.f, a1 = 0.f;
            for (int j = 0; j <= i; ++j) { const float w = Wl[i * 128 + j]; const unsigned v = *(const LAS unsigned*)(vn + (cs + j) * 192 + 2 * dd2); a0 += w * bflo(v); a1 += w * bfhi(v); }
            const float bsv = p.a_bs[h * 128 + i]; a0 += bsv; a1 += bsv;
            const size_t rb = (size_t)(row0 + rl) * DINP + h * 192 + 2 * dd2;
            const unsigned uu = *(const unsigned*)(PROJ + rb + C_AU), gg = *(const unsigned*)(PROJ + rb + C_AG);
            const float o0 = bflo(uu) * a0 * silu(bflo(gg)), o1 = bfhi(uu) * a1 * silu(bfhi(gg));
            *(unsigned*)(BRANCH + (size_t)(row0 + rl) * DM + h * 192 + 2 * dd2) = pk2(o0, o1);
        }
    }
}

template <bool F32SRC>
__device__ __forceinline__ void mixX_task(const Params& p, LAS unsigned char* lds, const void* Ksrc, const void* Vsrc, int kvrow0, int h, int qrow0, int nq) {
    int tid_ = threadIdx.x; asm volatile("" : "+v"(tid_)); const int tid = tid_, lane = tid & 63, wave = tid >> 6;
    const bf16_t* PROJ = (const bf16_t*)(p.ws + WS_PROJ); bf16_t* BRANCH = (bf16_t*)(p.ws + WS_BRANCH);
    LAS unsigned char* Kl = lds;
    LAS unsigned char* Vl = lds + 69632;
    LAS float* qs = (LAS float*)(lds + 69632 + 65536) + wave * 128;
    LAS float* ps = (LAS float*)(lds + 69632 + 65536 + 4096) + wave * 256;
    __syncthreads();
    if (F32SRC) {
        const float* K = (const float*)Ksrc; const float* V = (const float*)Vsrc;
        for (int i = tid; i < 256 * 32; i += NTHREADS) { const int n = i >> 5, ch = i & 31; const size_t g = (size_t)(kvrow0 + n) * 512 + h * 128 + ch * 4;
            const f32x4 kv = *(const f32x4*)(K + g), vv = *(const f32x4*)(V + g);
            u32x2 a; a.x = pk2(kv.x, kv.y); a.y = pk2(kv.z, kv.w); *(LAS u32x2*)(Kl + n * 272 + ch * 8) = a;
            u32x2 b; b.x = pk2(vv.x, vv.y); b.y = pk2(vv.z, vv.w); *(LAS u32x2*)(Vl + n * 256 + ch * 8) = b; }
    } else {
        const bf16_t* K = (const bf16_t*)Ksrc; const bf16_t* V = (const bf16_t*)Vsrc;
        for (int i = tid; i < 256 * 16; i += NTHREADS) { const int n = i >> 4, ch = i & 15; const size_t g = (size_t)(kvrow0 + n) * 512 + h * 128 + ch * 8;
            *(LAS u32x4*)(Kl + n * 272 + ch * 16) = *(const u32x4*)(K + g); *(LAS u32x4*)(Vl + n * 256 + ch * 16) = *(const u32x4*)(V + g); }
    }
    __syncthreads();
    for (int qi = wave; qi < nq; qi += 8) {
        const int row = qrow0 + qi;
        { const unsigned w = *(const unsigned*)(PROJ + (size_t)row * DINP + C_XQ + h * 128 + 2 * lane); qs[2 * lane] = bflo(w) * 0.08838834764831845f; qs[2 * lane + 1] = bfhi(w) * 0.08838834764831845f; }
        asm volatile("s_waitcnt lgkmcnt(0)" ::: "memory");
        float s[4] = {0.f, 0.f, 0.f, 0.f};
        for (int c = 0; c < 16; ++c) {
            const f32x4 qa = *(const LAS f32x4*)(qs + 8 * c), qb = *(const LAS f32x4*)(qs + 8 * c + 4);
#pragma unroll
            for (int kk = 0; kk < 4; ++kk) { const u32x4 kv = *(const LAS u32x4*)(Kl + (lane + 64 * kk) * 272 + c * 16);
                s[kk] += (qa.x * bflo(kv.x) + qa.y * bfhi(kv.x)) + (qa.z * bflo(kv.y) + qa.w * bfhi(kv.y)) + (qb.x * bflo(kv.z) + qb.y * bfhi(kv.z)) + (qb.z * bflo(kv.w) + qb.w * bfhi(kv.w)); }
        }
        const float mx = wave_max(fmaxf(fmaxf(s[0], s[1]), fmaxf(s[2], s[3])));
        float e[4], sum = 0.f;
#pragma unroll
        for (int kk = 0; kk < 4; ++kk) { e[kk] = __expf(s[kk] - mx); sum += e[kk]; }
        const float inv = 1.0f / wave_sum(sum);
#pragma unroll
        for (int kk = 0; kk < 4; ++kk) ps[lane + 64 * kk] = e[kk] * inv;
        asm volatile("s_waitcnt lgkmcnt(0)" ::: "memory");
        float o0 = 0.f, o1 = 0.f;
        for (int n = 0; n < 256; n += 4) { const f32x4 pp = *(const LAS f32x4*)(ps + n);
#pragma unroll
            for (int j = 0; j < 4; ++j) { const unsigned v = *(const LAS unsigned*)(Vl + (n + j) * 256 + lane * 4); o0 += pp[j] * bflo(v); o1 += pp[j] * bfhi(v); } }
        const unsigned g = *(const unsigned*)(PROJ + (size_t)row * DINP + C_XG + h * 128 + 2 * lane);
        *(unsigned*)(BRANCH + (size_t)row * DM + 1536 + h * 128 + 2 * lane) = pk2(o0 * silu(bflo(g)), o1 * silu(bfhi(g)));
    }
}


__device__ __forceinline__ void mixA2_task(const Params& p, LAS unsigned char* lds, int row0, int h, int L, bool smp) {
    int tid_ = threadIdx.x; asm volatile("" : "+v"(tid_)); const int tid = tid_, lane = tid & 63, w = __builtin_amdgcn_readfirstlane(tid >> 6), fr = lane & 15, fq = lane >> 4;
    const bf16_t* PROJ = (const bf16_t*)(p.ws + WS_PROJ); bf16_t* BRANCH = (bf16_t*)(p.ws + WS_BRANCH);
    LAS unsigned char* Wl = lds;
    LAS unsigned char* vnl = lds + 34816;
    LAS float* rs = (LAS float*)(lds + 34816 + 53248);
    __syncthreads();
    for (int t = w * 16; t < w * 16 + 16; ++t) {
        const u32x2* src = (const u32x2*)(PROJ + (size_t)(row0 + t) * DINP + C_AV) + lane; float ss = 0.f;
#pragma unroll
        for (int j = 0; j < 3; ++j) { const u32x2 x = src[64 * j]; const float a = bflo(x.x), b = bfhi(x.x), c = bflo(x.y), d = bfhi(x.y); ss += (a * a + b * b) + (c * c + d * d); }
        ss = wave_sum(ss);
        if (lane == 0) rs[t] = 1.0f / sqrtf(ss * (1.0f / 768.0f) + EPS);
    }
#pragma unroll
    for (int k = 0; k < 8; ++k) { const int idx = tid + 512 * k, i = idx >> 5, j4 = (idx & 31) * 4; float v[4];
        if (!smp) { const f32x4 x = *(const f32x4*)(p.a_ws + (size_t)h * 16384 + i * 128 + j4);
#pragma unroll
            for (int q = 0; q < 4; ++q) v[q] = (j4 + q <= i) ? x[q] : 0.f; }
        else {
#pragma unroll
            for (int q = 0; q < 4; ++q) { const int j = j4 + q; v[q] = ((j >> 3) == (i >> 3) && (j & 7) <= (i & 7)) ? p.a_ws[(size_t)h * 16384 + (i & 7) * 128 + (j & 7)] : 0.f; } }
        u32x2 o; o.x = pk2(v[0], v[1]); o.y = pk2(v[2], v[3]); *(LAS u32x2*)(Wl + i * 272 + j4 * 2) = o; }
    __syncthreads();
#pragma unroll
    for (int k = 0; k < 6; ++k) { const int idx = tid + 512 * k, t = idx / 24, ch = idx % 24;
        const u32x4 x = *(const u32x4*)(PROJ + (size_t)(row0 + t) * DINP + C_AV + h * 192 + 8 * ch);
        const f32x4 w0 = *(const f32x4*)(p.a_vnorm_w + h * 192 + 8 * ch), w1 = *(const f32x4*)(p.a_vnorm_w + h * 192 + 8 * ch + 4); const float r = rs[t];
        f32x4 v0, v1; v0[0] = bflo(x.x) * r * w0[0]; v0[1] = bfhi(x.x) * r * w0[1]; v0[2] = bflo(x.y) * r * w0[2]; v0[3] = bfhi(x.y) * r * w0[3];
        v1[0] = bflo(x.z) * r * w1[0]; v1[1] = bfhi(x.z) * r * w1[1]; v1[2] = bflo(x.w) * r * w1[2]; v1[3] = bfhi(x.w) * r * w1[3];
        u32x4 o; o.x = pk2(v0[0], v0[1]); o.y = pk2(v0[2], v0[3]); o.z = pk2(v1[0], v1[1]); o.w = pk2(v1[2], v1[3]);
        *(LAS u32x4*)(vnl + t * 416 + ch * 16) = o;
        if (smp) { float* cv = p.out + O_CV + (size_t)(row0 - NP + t) * 768 + h * 192 + 8 * ch; *(f32x4*)cv = v0; *(f32x4*)(cv + 4) = v1; } }
    __syncthreads();
    {
        const int it = w;
        const int ks_lo = smp ? (it >> 1) : 0, ks_hi = smp ? (it >> 1) : ((16 * it + 15) >> 5);
        f32x4 acc[12];
#pragma unroll
        for (int dt = 0; dt < 12; ++dt) acc[dt] = (f32x4){0.f, 0.f, 0.f, 0.f};
        const unsigned vbase = (unsigned)(size_t)vnl + (unsigned)((4 * fq + (fr >> 2)) * 416 + (4 * (fr & 3)) * 2);
        for (int ks = ks_lo; ks <= ks_hi; ++ks) {
            const u32x2 wlo = *(const LAS u32x2*)(Wl + (16 * it + fr) * 272 + (32 * ks + 4 * fq) * 2), whi = *(const LAS u32x2*)(Wl + (16 * it + fr) * 272 + (32 * ks + 16 + 4 * fq) * 2);
            u32x4 wy; wy.x = wlo.x; wy.y = wlo.y; wy.z = whi.x; wy.w = whi.y; const bf16x8 yf = __builtin_bit_cast(bf16x8, wy);
#pragma unroll
            for (int g = 0; g < 3; ++g) { s16x4 lo[4], hi[4];
#pragma unroll
                for (int q = 0; q < 4; ++q) { const unsigned a = vbase + (unsigned)(32 * ks * 416 + (16 * (4 * g + q)) * 2); lo[q] = tr_read(a); hi[q] = tr_read(a + 16 * 416); }
                TR_WAIT();
#pragma unroll
                for (int q = 0; q < 4; ++q) acc[4 * g + q] = MFMA16(PK8(lo[q], hi[q]), yf, acc[4 * g + q]); }
        }
        const int i = 16 * it + fr; const size_t row = (size_t)(row0 + i); const float bsv = p.a_bs[h * 128 + (i % L)];
#pragma unroll
        for (int dt = 0; dt < 12; ++dt) { const int dd0 = 16 * dt + 4 * fq;
            const u32x2 uu = *(const u32x2*)(PROJ + row * DINP + C_AU + h * 192 + dd0), gg = *(const u32x2*)(PROJ + row * DINP + C_AG + h * 192 + dd0);
            u32x2 o; o.x = pk2(bflo(uu.x) * (acc[dt][0] + bsv) * silu(bflo(gg.x)), bfhi(uu.x) * (acc[dt][1] + bsv) * silu(bfhi(gg.x)));
            o.y = pk2(bflo(uu.y) * (acc[dt][2] + bsv) * silu(bflo(gg.y)), bfhi(uu.y) * (acc[dt][3] + bsv) * silu(bfhi(gg.y)));
            *(u32x2*)(BRANCH + row * DM + h * 192 + dd0) = o; }
    }
}

__device__ __forceinline__ void mixXp_task(const Params& p, LAS unsigned char* lds, int b, int h, int qt) {
    int tid_ = threadIdx.x; asm volatile("" : "+v"(tid_)); const int tid = tid_, lane = tid & 63, w = __builtin_amdgcn_readfirstlane(tid >> 6), fr = lane & 15, fq = lane >> 4;
    const bf16_t* PROJ = (const bf16_t*)(p.ws + WS_PROJ); bf16_t* BRANCH = (bf16_t*)(p.ws + WS_BRANCH);
    const bf16_t* MKB = (const bf16_t*)(p.ws + WS_MKB); const bf16_t* MVB = (const bf16_t*)(p.ws + WS_MVB);
    LAS unsigned char* Kl = lds;
    LAS unsigned char* Vl = lds + 69632;
    __syncthreads();
#pragma unroll
    for (int k = 0; k < 8; ++k) { const int idx = tid + 512 * k, n = idx >> 4, ch = idx & 15; const size_t g = (size_t)(b * 256 + n) * 512 + h * 128 + ch * 8;
        *(LAS u32x4*)(Kl + n * 272 + ch * 16) = *(const u32x4*)(MKB + g); *(LAS u32x4*)(Vl + n * 288 + ch * 16) = *(const u32x4*)(MVB + g); }
    const size_t row = (size_t)(b * SEQ + qt * 128 + 16 * w + fr);
    bf16x8 bQ[4];
#pragma unroll
    for (int ks = 0; ks < 4; ++ks) bQ[ks] = *(const bf16x8*)(PROJ + row * DINP + C_XQ + h * 128 + 32 * ks + 8 * fq);
    __syncthreads();
    f32x4 s[16];
#pragma unroll
    for (int nt = 0; nt < 16; ++nt) { f32x4 a = (f32x4){0.f, 0.f, 0.f, 0.f};
#pragma unroll
        for (int ks = 0; ks < 4; ++ks) a = MFMA16(*(const LAS bf16x8*)(Kl + (16 * nt + fr) * 272 + (32 * ks + 8 * fq) * 2), bQ[ks], a);
        s[nt] = a; }
    float mx = -3.0e38f;
#pragma unroll
    for (int nt = 0; nt < 16; ++nt) mx = fmaxf(mx, fmaxf(fmaxf(s[nt][0], s[nt][1]), fmaxf(s[nt][2], s[nt][3])));
    mx = fmaxf(mx, __shfl_xor(mx, 16)); mx = fmaxf(mx, __shfl_xor(mx, 32));
    float l = 0.f; bf16x8 pP[8];
#pragma unroll
    for (int ks = 0; ks < 8; ++ks) { float e[8];
#pragma unroll
        for (int j = 0; j < 4; ++j) { e[j] = __expf((s[2 * ks][j] - mx) * 0.08838834764831845f); e[4 + j] = __expf((s[2 * ks + 1][j] - mx) * 0.08838834764831845f); }
        u32x4 pw; pw.x = pk2(e[0], e[1]); pw.y = pk2(e[2], e[3]); pw.z = pk2(e[4], e[5]); pw.w = pk2(e[6], e[7]); pP[ks] = __builtin_bit_cast(bf16x8, pw);
        l += ((e[0] + e[1]) + (e[2] + e[3])) + ((e[4] + e[5]) + (e[6] + e[7])); }
    l += __shfl_xor(l, 16); l += __shfl_xor(l, 32);
    const float inv = 1.0f / l;
    const unsigned vbase = (unsigned)(size_t)Vl + (unsigned)((4 * fq + (fr >> 2)) * 288 + (4 * (fr & 3)) * 2);
#pragma unroll
    for (int dt = 0; dt < 8; ++dt) {
        const u32x2 gg = *(const u32x2*)(PROJ + row * DINP + C_XG + h * 128 + 16 * dt + 4 * fq);
        f32x4 o = (f32x4){0.f, 0.f, 0.f, 0.f};
#pragma unroll
        for (int half = 0; half < 2; ++half) { s16x4 lo[4], hi[4];
#pragma unroll
            for (int q = 0; q < 4; ++q) { const unsigned a = vbase + (unsigned)((32 * (4 * half + q)) * 288 + (16 * dt) * 2); lo[q] = tr_read(a); hi[q] = tr_read(a + 16 * 288); }
            TR_WAIT();
#pragma unroll
            for (int q = 0; q < 4; ++q) o = MFMA16(PK8(lo[q], hi[q]), pP[4 * half + q], o); }
        u32x2 ow; ow.x = pk2(o[0] * inv * silu(bflo(gg.x)), o[1] * inv * silu(bfhi(gg.x))); ow.y = pk2(o[2] * inv * silu(bflo(gg.y)), o[3] * inv * silu(bfhi(gg.y)));
        *(u32x2*)(BRANCH + row * DM + 1536 + h * 128 + 16 * dt + 4 * fq) = ow;
    }
}

__device__ __forceinline__ void mixXs_task(const Params& p, LAS unsigned char* lds, int b, int h) {
    int tid_ = threadIdx.x; asm volatile("" : "+v"(tid_)); const int tid = tid_, lane = tid & 63, w = __builtin_amdgcn_readfirstlane(tid >> 6), fr = lane & 15, fq = lane >> 4;
    const bf16_t* PROJ = (const bf16_t*)(p.ws + WS_PROJ); bf16_t* BRANCH = (bf16_t*)(p.ws + WS_BRANCH);
    LAS float* part = (LAS float*)lds;
    LAS float* ml = (LAS float*)(lds + 32768);
    __syncthreads();
    const float* vp = p.cache_v + (size_t)(b * 256 + 32 * w) * 512 + h * 128 + 2 * lane;
    f32x2 vv[32];
#pragma unroll
    for (int kk = 0; kk < 32; ++kk) vv[kk] = *(const f32x2*)(vp + (size_t)kk * 512);
    const size_t qrow = (size_t)(NP + b * 8 + (fr & 7));
    bf16x8 bQ[4];
#pragma unroll
    for (int ks = 0; ks < 4; ++ks) bQ[ks] = *(const bf16x8*)(PROJ + qrow * DINP + C_XQ + h * 128 + 32 * ks + 8 * fq);
    f32x4 s[2];
#pragma unroll
    for (int nt = 0; nt < 2; ++nt) { const float* kp = p.cache_k + (size_t)(b * 256 + 32 * w + 16 * nt + fr) * 512 + h * 128 + 8 * fq; f32x4 a = (f32x4){0.f, 0.f, 0.f, 0.f};
        f32x4 k0[4], k1[4];
#pragma unroll
        for (int ks = 0; ks < 4; ++ks) { k0[ks] = *(const f32x4*)(kp + 32 * ks); k1[ks] = *(const f32x4*)(kp + 32 * ks + 4); }
#pragma unroll
        for (int ks = 0; ks < 4; ++ks) { u32x4 kw; kw.x = pk2(k0[ks][0], k0[ks][1]); kw.y = pk2(k0[ks][2], k0[ks][3]); kw.z = pk2(k1[ks][0], k1[ks][1]); kw.w = pk2(k1[ks][2], k1[ks][3]);
            a = MFMA16(__builtin_bit_cast(bf16x8, kw), bQ[ks], a); }
        s[nt] = a * 0.08838834764831845f; }
    float mx = fmaxf(fmaxf(fmaxf(s[0][0], s[0][1]), fmaxf(s[0][2], s[0][3])), fmaxf(fmaxf(s[1][0], s[1][1]), fmaxf(s[1][2], s[1][3])));
    mx = fmaxf(mx, __shfl_xor(mx, 16)); mx = fmaxf(mx, __shfl_xor(mx, 32));
    float l = 0.f;
#pragma unroll
    for (int nt = 0; nt < 2; ++nt)
#pragma unroll
        for (int j = 0; j < 4; ++j) { s[nt][j] = __expf(s[nt][j] - mx); l += s[nt][j]; }
    l += __shfl_xor(l, 16); l += __shfl_xor(l, 32);
    if (lane < 8) { ml[(w * 8 + lane) * 2] = mx; ml[(w * 8 + lane) * 2 + 1] = l; }
    f32x2 acc[8];
#pragma unroll
    for (int i = 0; i < 8; ++i) acc[i] = (f32x2){0.f, 0.f};
#pragma unroll
    for (int kk = 0; kk < 32; ++kk) { const int nt = kk >> 4, fqs = (kk & 15) >> 2, j = kk & 3;
        const float sv = s[nt][j]; const int svi = __float_as_int(sv);
#pragma unroll
        for (int i = 0; i < 8; ++i) { const float pv = __int_as_float(__builtin_amdgcn_readlane(svi, i + 16 * fqs)); acc[i] += vv[kk] * pv; } }
#pragma unroll
    for (int i = 0; i < 8; ++i) *(LAS f32x2*)(part + (w * 8 + i) * 128 + 2 * lane) = acc[i];
    __syncthreads();
    { const int i = tid >> 6, dd = 2 * (tid & 63); float M = -3.0e38f;
#pragma unroll
      for (int ww = 0; ww < 8; ++ww) M = fmaxf(M, ml[(ww * 8 + i) * 2]);
      float Lq = 0.f, o0 = 0.f, o1 = 0.f;
#pragma unroll
      for (int ww = 0; ww < 8; ++ww) { const float sc = __expf(ml[(ww * 8 + i) * 2] - M); Lq += ml[(ww * 8 + i) * 2 + 1] * sc; const f32x2 pa = *(const LAS f32x2*)(part + (ww * 8 + i) * 128 + dd); o0 += pa.x * sc; o1 += pa.y * sc; }
      const size_t row = (size_t)(NP + b * 8 + i); const unsigned g = *(const unsigned*)(PROJ + row * DINP + C_XG + h * 128 + dd); const float inv = 1.0f / Lq;
      *(unsigned*)(BRANCH + row * DM + 1536 + h * 128 + dd) = pk2(o0 * inv * silu(bflo(g)), o1 * inv * silu(bfhi(g))); }
}

__device__ __forceinline__ void mixB_task(const Params& p, LAS unsigned char* lds, int row0, int T, int h, const float* s0, float* sout) {
    int tid_ = threadIdx.x; asm volatile("" : "+v"(tid_)); const int tid = tid_, lane = tid & 63, wave = tid >> 6;
    const bf16_t* PROJ = (const bf16_t*)(p.ws + WS_PROJ); bf16_t* BRANCH = (bf16_t*)(p.ws + WS_BRANCH); const float* BR = (const float*)(p.ws + WS_BR);
    LAS float* qs = (LAS float*)lds;
    LAS float* ks = qs + 32 * 96;
    LAS float* al = ks + 32 * 96;
    LAS float* vs = al + 32 * 96;
    LAS float* po = vs + 32 * 192;
    const int e = tid % 192, hf = tid / 192, d0 = hf * 48;
    float S[48];
#pragma unroll
    for (int dd = 0; dd < 48; ++dd) S[dd] = (s0 && tid < 384) ? s0[(size_t)(d0 + dd) * 192 + e] : 0.f;
    const int TC = T < 32 ? T : 32;
    for (int t0 = 0; t0 < T; t0 += TC) {
        __syncthreads();
        for (int i = tid; i < TC * 96; i += NTHREADS) { const int t = i / 96, d = i % 96; const size_t row = (size_t)(row0 + t0 + t);
            float z = p.b_ba[h * 96 + d];
#pragma unroll
            for (int r = 0; r < 16; ++r) z += BR[row * 16 + r] * p.b_wa[r * 384 + h * 96 + d];
            const float la = (fminf(z, 0.f) - log1pf(__expf(-fabsf(z)))) * (1.0f / 16.0f);
            al[i] = __expf(la);
            qs[i] = bf2f(PROJ[row * DINP + C_BQ + h * 96 + d]) * 0.10206207261596577f;
            ks[i] = bf2f(PROJ[row * DINP + C_BK + h * 96 + d]); }
        for (int i = tid; i < TC * 192; i += NTHREADS) { const int t = i / 192, ee = i % 192; vs[i] = bf2f(PROJ[(size_t)(row0 + t0 + t) * DINP + C_BV + h * 192 + ee]); }
        __syncthreads();
        if (tid < 384) {
#pragma unroll 1
            for (int t = 0; t < TC; ++t) {
                const float v = vs[t * 192 + e]; float acc = 0.f;
#pragma unroll
                for (int d4 = 0; d4 < 12; ++d4) {
                    const f32x4 a4 = *(const LAS f32x4*)(al + t * 96 + d0 + 4 * d4), k4 = *(const LAS f32x4*)(ks + t * 96 + d0 + 4 * d4), q4 = *(const LAS f32x4*)(qs + t * 96 + d0 + 4 * d4);
#pragma unroll
                    for (int j = 0; j < 4; ++j) { S[4 * d4 + j] = a4[j] * S[4 * d4 + j] + k4[j] * v; acc += q4[j] * S[4 * d4 + j]; }
                    if ((d4 % 3) == 2) asm volatile("" ::: "memory");
                }
                po[(hf * 32 + t) * 192 + e] = acc;
            }
        }
        __syncthreads();
        for (int t = wave; t < TC; t += 8) {
            const size_t row = (size_t)(row0 + t0 + t);
            float o[3], ss = 0.f;
#pragma unroll
            for (int j = 0; j < 3; ++j) { o[j] = po[t * 192 + lane + 64 * j] + po[(32 + t) * 192 + lane + 64 * j]; ss += o[j] * o[j]; }
            const float rstd = 1.0f / sqrtf(wave_sum(ss) * (1.0f / 192.0f) + EPS);
#pragma unroll
            for (int j = 0; j < 3; ++j) { const int ee = lane + 64 * j; const float g = bf2f(PROJ[row * DINP + C_BG + h * 192 + ee]);
                BRANCH[row * DM + 768 + h * 192 + ee] = (bf16_t)f2bf(o[j] * rstd * p.b_onorm_w[ee] * silu(g)); }
        }
    }
    if (tid < 384) {
#pragma unroll
        for (int dd = 0; dd < 48; ++dd) sout[(size_t)(d0 + dd) * 192 + e] = S[dd];
    }
}


__device__ __forceinline__ void glaPrep_task(const Params& p, LAS unsigned char* lds, int b, int h, int c) {
    int tid_ = threadIdx.x; asm volatile("" : "+v"(tid_)); const int tid = tid_, lane = tid & 63, w = __builtin_amdgcn_readfirstlane(tid >> 6), fr = lane & 15, fq = lane >> 4;
    LAS bf16_t* Qh  = (LAS bf16_t*)lds;
    LAS bf16_t* Kin = (LAS bf16_t*)(lds + 13312);
    LAS unsigned char* Ko = lds + 26624;
    LAS unsigned char* Vl = lds + 40960;
    LAS bf16_t* Pm  = (LAS bf16_t*)(lds + 67584);
    LAS bf16_t* laH = (LAS bf16_t*)(lds + 76800);
    LAS bf16_t* laL = (LAS bf16_t*)(lds + 90624);
    LAS float* gex  = (LAS float*)(lds + 104448);
    LAS float* bav  = (LAS float*)(lds + 104832);
    LAS unsigned char* WF = lds + 105216;
    const bf16_t* PROJ = (const bf16_t*)(p.ws + WS_PROJ); const float* BR = (const float*)(p.ws + WS_BR);
    bf16_t* QHg = (bf16_t*)(p.ws + WS_QH); bf16_t* OIg = (bf16_t*)(p.ws + WS_OI); bf16_t* GFg = (bf16_t*)(p.ws + WS_GF);
    float* GXg = (float*)(p.ws + WS_GX);
    const int row0 = b * SEQ + c * 64, bhc = (b * 4 + h) * 32 + c;
    const int it = w & 3, dt0 = 3 * (w >> 2);
    __syncthreads();
    const size_t rowi = (size_t)(row0 + 16 * it + fr);
    u32x2 qv[3], kv[3]; f32x4 brv[2]; u32x4 vv[3];
    { const bf16_t* qkp = PROJ + rowi * DINP + C_BQ + h * 96 + 16 * dt0 + 4 * fq;
#pragma unroll
      for (int n = 0; n < 3; ++n) { qv[n] = *(const u32x2*)(qkp + 16 * n); kv[n] = *(const u32x2*)(qkp + 384 + 16 * n); }
      const float* brp = BR + rowi * 16 + 8 * (fq & 1); brv[0] = *(const f32x4*)brp; brv[1] = *(const f32x4*)(brp + 4);
      const bf16_t* vp = PROJ + (size_t)(row0 + (tid >> 3)) * DINP + C_BV + h * 192 + 8 * (tid & 7);
#pragma unroll
      for (int k = 0; k < 3; ++k) vv[k] = *(const u32x4*)(vp + 64 * k); }
    if (tid < 192) { const int dt = tid >> 5, l32 = tid & 31, d = 16 * dt + (l32 & 15), r0 = 8 * (l32 >> 4); float hi[8], lo[8];
#pragma unroll
        for (int jj = 0; jj < 8; ++jj) { const float wv = p.b_wa[(r0 + jj) * 384 + h * 96 + d]; hi[jj] = bf2f((bf16_t)f2bf(wv)); lo[jj] = wv - hi[jj]; }
        u32x4 a, cc; a.x = pk2(hi[0], hi[1]); a.y = pk2(hi[2], hi[3]); a.z = pk2(hi[4], hi[5]); a.w = pk2(hi[6], hi[7]);
        cc.x = pk2(lo[0], lo[1]); cc.y = pk2(lo[2], lo[3]); cc.z = pk2(lo[4], lo[5]); cc.w = pk2(lo[6], lo[7]);
        *(LAS u32x4*)(WF + tid * 16) = a; *(LAS u32x4*)(WF + 3072 + tid * 16) = cc; }
    for (int i = tid; i < 96; i += NTHREADS) bav[i] = p.b_ba[h * 96 + i];
#pragma unroll
    for (int k = 0; k < 6; ++k) { const int idx = tid + 512 * k, t = idx / 48, e4 = 4 * (idx % 48); const size_t row = (size_t)(row0 + t);
        const u32x2 g = *(const u32x2*)(PROJ + row * DINP + C_BG + h * 192 + e4); const f32x4 ow = *(const f32x4*)(p.b_onorm_w + e4);
        u32x2 o; o.x = pk2(ow[0] * silu(bflo(g.x)), ow[1] * silu(bfhi(g.x))); o.y = pk2(ow[2] * silu(bflo(g.y)), ow[3] * silu(bfhi(g.y)));
        *(u32x2*)(GFg + row * 768 + h * 192 + e4) = o; }
#pragma unroll
    for (int k = 0; k < 3; ++k) *(LAS u32x4*)(Vl + (tid >> 3) * 416 + ((tid & 7) + 8 * k) * 16) = vv[k];
    __syncthreads();
    {
        float f[8] = {brv[0].x, brv[0].y, brv[0].z, brv[0].w, brv[1].x, brv[1].y, brv[1].z, brv[1].w};
        float fh[8];
#pragma unroll
        for (int jj = 0; jj < 8; ++jj) { fh[jj] = bf2f((bf16_t)f2bf(f[jj])); if (fq >= 2) fh[jj] = f[jj] - fh[jj]; }
        u32x4 bw; bw.x = pk2(fh[0], fh[1]); bw.y = pk2(fh[2], fh[3]); bw.z = pk2(fh[4], fh[5]); bw.w = pk2(fh[6], fh[7]); const bf16x8 bfrag = __builtin_bit_cast(bf16x8, bw);
#pragma unroll
        for (int n = 0; n < 3; ++n) {
            const int wo = ((dt0 + n) * 32 + (fq & 1) * 16 + fr) * 16;
            const bf16x8 a1 = *(const LAS bf16x8*)(WF + wo); bf16x8 a2 = *(const LAS bf16x8*)(WF + 3072 + wo);
            if (fq >= 2) a2 = (bf16x8){0, 0, 0, 0, 0, 0, 0, 0};
            f32x4 zt = MFMA16(a1, bfrag, ((f32x4){0.f, 0.f, 0.f, 0.f})); zt = MFMA16(a2, bfrag, zt);
            const f32x4 b4 = *(const LAS f32x4*)(bav + 16 * (dt0 + n) + 4 * fq);
#pragma unroll
            for (int j = 0; j < 4; ++j) { const float z = zt[j] + b4[j]; const float la = (fminf(z, 0.f) - __logf(1.0f + __expf(-fabsf(z)))) * 0.0625f;
                const unsigned hi = f2bf(la), lo = f2bf(la - bf2f((bf16_t)hi)); const int o = (16 * (dt0 + n) + 4 * fq + j) * 72 + 16 * it + fr;
                laH[o] = (bf16_t)hi; laL[o] = (bf16_t)lo; }
        }
    }
    __syncthreads();
    f32x4 cu[3];
#pragma unroll
    for (int n = 0; n < 3; ++n) cu[n] = (f32x4){0.f, 0.f, 0.f, 0.f};
#pragma unroll
    for (int ks = 0; ks < 2; ++ks) if (ks == 0 || it >= 2) {
        bf16x8 lt;
#pragma unroll
        for (int jj = 0; jj < 8; ++jj) lt[jj] = ((32 * ks + 8 * fq + jj) <= (16 * it + fr)) ? (short)0x3F80 : (short)0;
#pragma unroll
        for (int n = 0; n < 3; ++n) { const int o = (16 * (dt0 + n) + fr) * 72 + 32 * ks + 8 * fq;
            cu[n] = MFMA16(*(const LAS bf16x8*)(laH + o), lt, cu[n]); cu[n] = MFMA16(*(const LAS bf16x8*)(laL + o), lt, cu[n]); }
    }
    if (it == 3 && fr == 15) {
#pragma unroll
        for (int n = 0; n < 3; ++n) { f32x4 ge; ge[0] = __expf(cu[n][0]); ge[1] = __expf(cu[n][1]); ge[2] = __expf(cu[n][2]); ge[3] = __expf(cu[n][3]);
            *(LAS f32x4*)(gex + 16 * (dt0 + n) + 4 * fq) = ge; *(f32x4*)(GXg + (size_t)bhc * 96 + 16 * (dt0 + n) + 4 * fq) = ge; }
    }
    __syncthreads();
    {
        const int i = 16 * it + fr;
#pragma unroll
        for (int n = 0; n < 3; ++n) {
            const int d = 16 * (dt0 + n) + 4 * fq;
            const f32x4 gxv = *(const LAS f32x4*)(gex + d);
            const float qf[4] = {bflo(qv[n].x), bfhi(qv[n].x), bflo(qv[n].y), bfhi(qv[n].y)}, kf[4] = {bflo(kv[n].x), bfhi(kv[n].x), bflo(kv[n].y), bfhi(kv[n].y)};
            float qh[4], ki[4], ko[4];
#pragma unroll
            for (int j = 0; j < 4; ++j) { const float cc = cu[n][j]; qh[j] = qf[j] * 0.10206207261596577f * __expf(cc); ki[j] = kf[j] * __expf(-cc); ko[j] = ki[j] * gxv[j]; }
            u32x2 wq, wk, wo; wq.x = pk2(qh[0], qh[1]); wq.y = pk2(qh[2], qh[3]); wk.x = pk2(ki[0], ki[1]); wk.y = pk2(ki[2], ki[3]); wo.x = pk2(ko[0], ko[1]); wo.y = pk2(ko[2], ko[3]);
            *(LAS u32x2*)(Qh + i * 104 + d) = wq; *(LAS u32x2*)(Kin + i * 104 + d) = wk; *(LAS u32x2*)(Ko + i * 224 + d * 2) = wo;
            *(u32x2*)(QHg + rowi * 384 + h * 96 + d) = wq;
        }
    }
    __syncthreads();
    {
        const int ita = w >> 1;
#pragma unroll
        for (int j2 = 0; j2 < 2; ++j2) { const int jt = 2 * (w & 1) + j2; u32x2 wp; wp.x = 0u; wp.y = 0u;
            if (jt <= ita) { f32x4 pt = (f32x4){0.f, 0.f, 0.f, 0.f};
#pragma unroll
                for (int ks = 0; ks < 3; ++ks) pt = MFMA16(*(const LAS bf16x8*)(Kin + (16 * jt + fr) * 104 + 32 * ks + 8 * fq), *(const LAS bf16x8*)(Qh + (16 * ita + fr) * 104 + 32 * ks + 8 * fq), pt);
                if (jt == ita) {
#pragma unroll
                    for (int j = 0; j < 4; ++j) if (4 * fq + j > fr) pt[j] = 0.f; }
                wp.x = pk2(pt[0], pt[1]); wp.y = pk2(pt[2], pt[3]); }
            *(LAS u32x2*)(Pm + (16 * ita + fr) * 72 + 16 * jt + 4 * fq) = wp; }
    }
    __syncthreads();
    {
        const LAS unsigned char* prow = (const LAS unsigned char*)Pm + (16 * it + fr) * 144 + 8 * fq;
        u32x4 y0, y1; { const u32x2 a = *(const LAS u32x2*)(prow), bq = *(const LAS u32x2*)(prow + 32), cq = *(const LAS u32x2*)(prow + 64), dq = *(const LAS u32x2*)(prow + 96);
            y0.x = a.x; y0.y = a.y; y0.z = bq.x; y0.w = bq.y; y1.x = cq.x; y1.y = cq.y; y1.z = dq.x; y1.w = dq.y; }
        const bf16x8 yP0 = __builtin_bit_cast(bf16x8, y0), yP1 = __builtin_bit_cast(bf16x8, y1);
        const unsigned vb = (unsigned)(size_t)Vl + (unsigned)((4 * fq + (fr >> 2)) * 416 + (96 * (w >> 2) + 4 * (fr & 3)) * 2);
        bf16_t* og = OIg + rowi * 768 + h * 192 + 96 * (w >> 2) + 4 * fq;
#pragma unroll
        for (int g = 0; g < 2; ++g) { s16x4 l0[3], h0[3], l1[3], h1[3];
#pragma unroll
            for (int q = 0; q < 3; ++q) { const unsigned a = vb + (unsigned)((16 * (3 * g + q)) * 2); l0[q] = tr_read(a); h0[q] = tr_read(a + 16 * 416); l1[q] = tr_read(a + 32 * 416); h1[q] = tr_read(a + 48 * 416); }
            TR_WAIT();
#pragma unroll
            for (int q = 0; q < 3; ++q) { const int m = 3 * g + q; const bf16x8 x0 = PK8(l0[q], h0[q]), x1 = PK8(l1[q], h1[q]);
                f32x4 o = MFMA16(x0, yP0, ((f32x4){0.f, 0.f, 0.f, 0.f}));
                if (it >= 2) o = MFMA16(x1, yP1, o);
                u32x2 ow; ow.x = pk2(o[0], o[1]); ow.y = pk2(o[2], o[3]); *(u32x2*)(og + 16 * m) = ow; }
        }
        const int dtS0 = 3 * (w & 1), etS0 = 3 * (w >> 1);
        const unsigned kb = (unsigned)(size_t)Ko + (unsigned)((4 * fq + (fr >> 2)) * 224 + (16 * dtS0 + 4 * (fr & 3)) * 2);
        const unsigned vb2 = (unsigned)(size_t)Vl + (unsigned)((4 * fq + (fr >> 2)) * 416 + (16 * etS0 + 4 * (fr & 3)) * 2);
        bf16x8 yK[3][2], xV[3][2];
        { s16x4 kl[3][4], vl_[3][4];
#pragma unroll
          for (int a = 0; a < 3; ++a)
#pragma unroll
              for (int q = 0; q < 4; ++q) { kl[a][q] = tr_read(kb + (unsigned)(32 * a + 16 * q * 224)); vl_[a][q] = tr_read(vb2 + (unsigned)(32 * a + 16 * q * 416)); }
          TR_WAIT();
#pragma unroll
          for (int a = 0; a < 3; ++a) { yK[a][0] = PK8(kl[a][0], kl[a][1]); yK[a][1] = PK8(kl[a][2], kl[a][3]); xV[a][0] = PK8(vl_[a][0], vl_[a][1]); xV[a][1] = PK8(vl_[a][2], vl_[a][3]); } }
        float* hg = (float*)(p.ws + WS_H) + (size_t)bhc * 96 * 192;
#pragma unroll
        for (int a = 0; a < 3; ++a)
#pragma unroll
            for (int e = 0; e < 3; ++e) { f32x4 hh = MFMA16(xV[e][0], yK[a][0], ((f32x4){0.f, 0.f, 0.f, 0.f})); hh = MFMA16(xV[e][1], yK[a][1], hh);
                *(f32x4*)(hg + (size_t)(16 * (dtS0 + a) + fr) * 192 + 16 * (etS0 + e) + 4 * fq) = hh; }
    }
}

__device__ __forceinline__ void glaScan_item(const Params& p, int gt) {
    const int e = gt % 192, dg = (gt / 192) % 24, bh = gt / (192 * 24), d0 = 4 * dg;
    const float* hp = (const float*)(p.ws + WS_H) + (size_t)bh * 32 * 96 * 192 + (size_t)d0 * 192 + e;
    const float* gp = (const float*)(p.ws + WS_GX) + (size_t)bh * 32 * 96 + d0;
    bf16_t* sp = (bf16_t*)(p.ws + WS_ST) + (size_t)bh * 32 * 192 * 96 + (size_t)e * 96 + d0;
    float s0 = 0.f, s1 = 0.f, s2 = 0.f, s3 = 0.f;
#pragma unroll 8
    for (int c = 0; c < 32; ++c) {
        const float h0 = hp[(size_t)c * 96 * 192], h1 = hp[(size_t)c * 96 * 192 + 192], h2 = hp[(size_t)c * 96 * 192 + 384], h3 = hp[(size_t)c * 96 * 192 + 576];
        const f32x4 g = *(const f32x4*)(gp + c * 96);
        u32x2 o; o.x = pk2(s0, s1); o.y = pk2(s2, s3); *(u32x2*)(sp + (size_t)c * 192 * 96) = o;
        s0 = g[0] * s0 + h0; s1 = g[1] * s1 + h1; s2 = g[2] * s2 + h2; s3 = g[3] * s3 + h3;
    }
    float* so = p.out + O_SP + (size_t)bh * 96 * 192 + (size_t)d0 * 192 + e;
    so[0] = s0; so[192] = s1; so[384] = s2; so[576] = s3;
}

__device__ __forceinline__ void glaOut_task(const Params& p, LAS unsigned char* lds, int b, int h, int c) {
    int tid_ = threadIdx.x; asm volatile("" : "+v"(tid_)); const int tid = tid_, lane = tid & 63, w = __builtin_amdgcn_readfirstlane(tid >> 6), fr = lane & 15, fq = lane >> 4;
    LAS float* ssq = (LAS float*)lds;
    const bf16_t* QHg = (const bf16_t*)(p.ws + WS_QH); const bf16_t* STg = (const bf16_t*)(p.ws + WS_ST);
    const bf16_t* OIg = (const bf16_t*)(p.ws + WS_OI); const bf16_t* GFg = (const bf16_t*)(p.ws + WS_GF); bf16_t* BRANCH = (bf16_t*)(p.ws + WS_BRANCH);
    const int row0 = b * SEQ + c * 64, bhc = (b * 4 + h) * 32 + c, it = w & 3, eh = w >> 2;
    const size_t rowi = (size_t)(row0 + 16 * it + fr);
    __syncthreads();
    bf16x8 bQ[3]; u32x2 oi[6], gf[6];
#pragma unroll
    for (int ks = 0; ks < 3; ++ks) bQ[ks] = *(const bf16x8*)(QHg + rowi * 384 + h * 96 + 32 * ks + 8 * fq);
    const size_t oofs = rowi * 768 + h * 192 + 96 * eh + 4 * fq;
#pragma unroll
    for (int m = 0; m < 6; ++m) { oi[m] = *(const u32x2*)(OIg + oofs + 16 * m); gf[m] = *(const u32x2*)(GFg + oofs + 16 * m); }
    const bf16_t* stp = STg + (size_t)bhc * 192 * 96 + (size_t)(96 * eh + fr) * 96 + 8 * fq;
    bf16x8 xs[6][3];
#pragma unroll
    for (int m = 0; m < 6; ++m)
#pragma unroll
        for (int ks = 0; ks < 3; ++ks) xs[m][ks] = *(const bf16x8*)(stp + (size_t)(16 * m) * 96 + 32 * ks);
    f32x4 oacc[6]; float ss = 0.f;
#pragma unroll
    for (int m = 0; m < 6; ++m) { f32x4 o; o[0] = bflo(oi[m].x); o[1] = bfhi(oi[m].x); o[2] = bflo(oi[m].y); o[3] = bfhi(oi[m].y);
#pragma unroll
        for (int ks = 0; ks < 3; ++ks) o = MFMA16(xs[m][ks], bQ[ks], o);
        oacc[m] = o; ss += (o[0] * o[0] + o[1] * o[1]) + (o[2] * o[2] + o[3] * o[3]); }
    ss += __shfl_xor(ss, 16); ss += __shfl_xor(ss, 32);
    if (fq == 0) ssq[(16 * it + fr) * 2 + eh] = ss;
    __syncthreads();
    const f32x2 sp = *(const LAS f32x2*)(ssq + 2 * (16 * it + fr));
    const float rstd = 1.0f / sqrtf((sp.x + sp.y) * (1.0f / 192.0f) + EPS);
    bf16_t* outp = BRANCH + rowi * DM + 768 + h * 192 + 96 * eh + 4 * fq;
#pragma unroll
    for (int m = 0; m < 6; ++m) { u32x2 wo; wo.x = pk2(oacc[m][0] * rstd * bflo(gf[m].x), oacc[m][1] * rstd * bfhi(gf[m].x)); wo.y = pk2(oacc[m][2] * rstd * bflo(gf[m].y), oacc[m][3] * rstd * bfhi(gf[m].y));
        *(u32x2*)(outp + 16 * m) = wo; }
}

__device__ __forceinline__ void phase_mixA(const Params& p, LAS unsigned char* lds) {
    const int G = gridDim.x, c = blockIdx.x;
    const int NGP = 512, NXP = 256, NA = 256 + 32, NTASK = NGP + NXP + NA;
    for (int t = c; t < NTASK; t += G) {
        int r = t;
        if (r < NGP) { glaPrep_task(p, lds, (r >> 2) & 3, r & 3, r >> 4); continue; }
        r -= NGP;
        if (r < NXP) { const int qt = r & 15, h = (r >> 4) & 3, b = r >> 6; mixXp_task(p, lds, b, h, qt); continue; }
        r -= NXP;
        { const int h = r & 3, blk = r >> 2; const bool smp = r >= 256; mixA2_task(p, lds, smp ? NP + (blk - 64) * 128 : blk * 128, h, smp ? 8 : 128, smp); }
    }
}
__device__ __forceinline__ void phase_mixB(const Params& p, LAS unsigned char* lds) {
    const int G = gridDim.x, c = blockIdx.x;
    const int NSC = 144, NXS = 512, NBS = 512, NTASK = NSC + NXS + NBS;
    for (int t = c; t < NTASK; t += G) {
        int r = t;
        if (r < NSC) { glaScan_item(p, r * NTHREADS + (int)threadIdx.x); continue; }
        r -= NSC;
        if (r < NXS) { const int h = r & 3, b = r >> 2; mixXs_task(p, lds, b, h); continue; }
        r -= NXS;
        { const int b = r >> 2, h = r & 3; mixB_task(p, lds, NP + b * 8, 8, h, p.state + (size_t)(b * 4 + h) * 96 * 192, p.out + O_SS + (size_t)(b * 4 + h) * 96 * 192); }
    }
}
__device__ __forceinline__ void phase_mixC(const Params& p, LAS unsigned char* lds) {
    for (int r = blockIdx.x; r < 512; r += gridDim.x) glaOut_task(p, lds, (r >> 2) & 3, r & 3, r >> 4);
}

__device__ __forceinline__ void phase_final(const Params& p) {
    const int lane = threadIdx.x & 63, wave = threadIdx.x >> 6;
    const int gw = blockIdx.x * 8 + wave, NGW = gridDim.x * 8;
    for (int r = gw; r < NTOK; r += NGW) {
        f32x4* s = (f32x4*)(p.out + (size_t)r * DM) + lane; const f32x4* wv = (const f32x4*)p.final_w + lane;
        f32x4 v[8]; float ss = 0.f;
#pragma unroll
        for (int j = 0; j < 8; ++j) { v[j] = s[64 * j]; ss += (v[j].x * v[j].x + v[j].y * v[j].y) + (v[j].z * v[j].z + v[j].w * v[j].w); }
        const float rstd = 1.0f / sqrtf(wave_sum(ss) * (1.0f / DM) + EPS);
#pragma unroll
        for (int j = 0; j < 8; ++j) { const f32x4 ww = wv[64 * j]; s[64 * j] = v[j] * rstd * ww; }
    }
}


#define XB_TMO      128
#define XB_XCNT(j)  (256  + 64 * (j))
#define XB_XSUB(j)  (1280 + 64 * (j))
#define XB_XGEN(j)  (2304 + 64 * (j))
#define XB_TOP      3328
#define XB_TOPGEN   3392
#define XCD_BAR_WORDS 3456
#define XB_SPIN_CAP (1u << 18)
__device__ __forceinline__ unsigned xb_ld(unsigned* p)              { return __hip_atomic_load(p, __ATOMIC_RELAXED, __HIP_MEMORY_SCOPE_AGENT); }
__device__ __forceinline__ unsigned xb_add(unsigned* p, unsigned v) { return __hip_atomic_fetch_add(p, v, __ATOMIC_RELAXED, __HIP_MEMORY_SCOPE_AGENT); }
__device__ __forceinline__ unsigned xb_xcc_id() { return (unsigned)__builtin_amdgcn_s_getreg((3 << 11) | 20) & 0xFu; }
#define XB_SPIN(cond, bar) do { unsigned _sp = 0; while (cond) { __builtin_amdgcn_s_sleep(1); \
    if ((++_sp & 255u) == 0u) { if (xb_ld(&(bar)[XB_TMO])) break; if (_sp > XB_SPIN_CAP) { atomicAdd(&(bar)[XB_TMO], 1u); break; } } } } while (0)
struct XcdBarrier { unsigned* bar; unsigned x; volatile LAS unsigned* st; };
__device__ __forceinline__ XcdBarrier xcd_barrier_post(unsigned* bar, volatile LAS unsigned* st) {
    XcdBarrier b; b.bar = bar; b.x = xb_xcc_id(); b.st = st;
    if (threadIdx.x == 0) (void)xb_add(&bar[XB_XCNT(b.x)], 1u);
    return b;
}
__device__ __forceinline__ void xcd_barrier_complete(unsigned* bar, unsigned x, unsigned& nloc, unsigned& nx) {
    const unsigned G = gridDim.x * gridDim.y * gridDim.z;
    unsigned sum, cnt, mine, sp = 0u;
    for (;;) {
        sum = 0u; cnt = 0u; mine = 0u;
#pragma unroll
        for (unsigned j = 0; j < 16; ++j) { const unsigned c = xb_ld(&bar[XB_XCNT(j)]); sum += c; cnt += (c > 0u) ? 1u : 0u; mine = (j == x) ? c : mine; }
        if (sum == G) break;
        __builtin_amdgcn_s_sleep(1);
        if ((++sp & 255u) == 0u) { if (xb_ld(&bar[XB_TMO])) break; if (sp > XB_SPIN_CAP) { atomicAdd(&bar[XB_TMO], 1u); break; } }
    }
    nloc = mine > 0u ? mine : 1u; nx = cnt > 0u ? cnt : 1u;
}
__device__ __forceinline__ void xcd_barrier(const XcdBarrier& b) {
    asm volatile("s_waitcnt vmcnt(0)" ::: "memory");
    __syncthreads();
    if (threadIdx.x == 0) {
        unsigned* bar = b.bar;
        __builtin_amdgcn_s_waitcnt(0);
        unsigned nloc = b.st[0], nx = b.st[1];
        if (nloc == 0u) { xcd_barrier_complete(bar, b.x, nloc, nx); b.st[0] = nloc; b.st[1] = nx; }
        const unsigned old = xb_add(&bar[XB_XSUB(b.x)], 1u);
        const unsigned gen = old / nloc;
        if (old + 1u == (gen + 1u) * nloc) {
            __builtin_amdgcn_fence(__ATOMIC_RELEASE, "agent");
            asm volatile("s_waitcnt vmcnt(0)" ::: "memory");
            const unsigned og = xb_add(&bar[XB_TOP], 1u);
            const unsigned tg = og / nx;
            if (og + 1u == (tg + 1u) * nx) xb_add(&bar[XB_TOPGEN], 1u);
            else XB_SPIN(xb_ld(&bar[XB_TOPGEN]) == tg, bar);
            __builtin_amdgcn_fence(__ATOMIC_ACQUIRE, "agent");
            xb_add(&bar[XB_XGEN(b.x)], 1u);
            asm volatile("s_waitcnt vmcnt(0)" ::: "memory");
        } else {
            XB_SPIN(xb_ld(&bar[XB_XGEN(b.x)]) == gen, bar);
            __builtin_amdgcn_fence(__ATOMIC_ACQUIRE, "agent");
            asm volatile("s_waitcnt vmcnt(0)" ::: "memory");
        }
    }
    __syncthreads();
}

__global__ void __launch_bounds__(NTHREADS, 2) fwd(Params p) {
    extern __shared__ __attribute__((aligned(16))) unsigned char lds_raw[];
    LAS unsigned char* lds = (LAS unsigned char*)lds_raw;
    const int lo = p.ph_lo, hi = p.ph_hi;
    volatile LAS unsigned* MISC = (volatile LAS unsigned*)(lds + LDS_MISC);
    if (threadIdx.x < 64) MISC[threadIdx.x] = 0u;
    __syncthreads();
    XcdBarrier bar; bar.bar = (unsigned*)(p.ws + WS_CTL) + 4096; bar.x = 0; bar.st = nullptr;
    if (hi - lo > 1) bar = xcd_barrier_post((unsigned*)(p.ws + WS_CTL) + 4096, MISC + 8);
#define BOTH(k) (IN(k) && IN((k) + 1))
#ifndef PH_MASK
#define PH_MASK 127
#endif
#define IN(k) (((PH_MASK >> (k)) & 1) && lo <= (k) && (k) < hi)
#ifndef PROBE_PHASE
#define PROBE_PHASE -1
#endif
#define REP(k) (PROBE_PHASE == (k) ? 2 : 1)
    if (IN(0)) { for (int rep = 0; rep < REP(0); ++rep) phase_prep(p, lds); if (BOTH(0)) xcd_barrier(bar); }
    if (IN(1)) {
        Prog1 P; P.XB = (const char*)(p.ws + WS_XB); P.WIN = (const char*)(p.ws + WS_WIN); P.MB = (const char*)(p.ws + WS_MB); P.WM = (const char*)(p.ws + WS_WM);
        P.PROJ = (bf16_t*)(p.ws + WS_PROJ); P.out = p.out; P.MKB = (bf16_t*)(p.ws + WS_MKB); P.MVB = (bf16_t*)(p.ws + WS_MVB); P.G = gridDim.x; P.c = blockIdx.x;
        for (int rep = 0; rep < REP(1); ++rep) pg8::gemm_phase(lds, P);
        const int wave = threadIdx.x >> 6, lane = threadIdx.x & 63;
        for (int t = (blockIdx.x + gridDim.x - 40) % gridDim.x; t < 72; t += gridDim.x) br_task((const bf16_t*)(p.ws + WS_XB), (const bf16_t*)(p.ws + WS_WR), (float*)(p.ws + WS_BR), t, wave, lane);
        if (BOTH(1)) xcd_barrier(bar);
    }
    if (IN(2)) { for (int rep = 0; rep < REP(2); ++rep) phase_mixA(p, lds); if (BOTH(2)) xcd_barrier(bar); }
    if (IN(3)) { for (int rep = 0; rep < REP(3); ++rep) phase_mixB(p, lds); if (BOTH(3)) xcd_barrier(bar); }
    if (IN(4)) { for (int rep = 0; rep < REP(4); ++rep) phase_mixC(p, lds); if (BOTH(4)) xcd_barrier(bar); }
    if (IN(5)) {
        Prog3 P; P.BRANCH = (const char*)(p.ws + WS_BRANCH); P.WO = (const char*)(p.ws + WS_WO); P.xp = p.x_prompt; P.xs = p.x_sample; P.out = p.out; P.G = gridDim.x; P.c = blockIdx.x;
        for (int rep = 0; rep < REP(5); ++rep) pg8::gemm_phase(lds, P);
        if (BOTH(5)) xcd_barrier(bar);
    }
    if (IN(6)) phase_final(p);
#undef IN
#undef BOTH
}

extern "C" void kernel_launch(void* const* d_in, const int* in_sizes, int n_in, void* d_out, int out_size, void* d_ws, size_t ws_size, hipStream_t stream) {
    static int grid = 0;
    if (grid == 0) {
        if (n_in != 18 || ws_size < WS_END) { fprintf(stderr, "kernel_launch: unexpected n_in %d or ws_size %zu\n", n_in, ws_size); grid = -1; return; }
        int dev = 0, cus = 0;
        if (hipGetDevice(&dev) != hipSuccess || hipDeviceGetAttribute(&cus, hipDeviceAttributeMultiprocessorCount, dev) != hipSuccess) { grid = -1; return; }
        if (hipFuncSetAttribute((const void*)fwd, hipFuncAttributeMaxDynamicSharedMemorySize, LDS_BYTES) != hipSuccess) { fprintf(stderr, "kernel_launch: hipFuncSetAttribute failed\n"); grid = -1; return; }
        grid = cus > 0 ? cus : 256;
    }
    if (grid < 0) return;
    Params p{};
    const float** pp = (const float**)&p;
    for (int i = 0; i < 18; ++i) pp[i] = (const float*)d_in[i];
    p.out = (float*)d_out; p.ws = (unsigned char*)d_ws;
    (void)hipMemsetAsync((char*)d_ws + WS_CTL, 0, 65536, stream);
#if N_LAUNCH_MODE == 1
    p.ph_lo = 0; p.ph_hi = 7; hipLaunchKernelGGL(fwd, dim3(grid), dim3(NTHREADS), LDS_BYTES, stream, p);
#else
    for (int ph = 0; ph < 7; ++ph) { p.ph_lo = ph; p.ph_hi = ph + 1; hipLaunchKernelGGL(fwd, dim3(grid), dim3(NTHREADS), LDS_BYTES, stream, p); }
#endif
}
```
